# Optimizing an MI355X kernel written in HIP

```python
import jax, jax.numpy as jnp
from jax import lax
import numpy as np


D_MODEL = 1024
BATCH = 8
SEQ = 4096
DEPTH = 4

CHUNK = 64
EPS = 1e-6
LB_FLOOR = 1e-30
N_BRANCH = 4
BRANCH_W = D_MODEL // 2

GLA_HEADS = 4
GLA_DK = 64
GLA_DV = BRANCH_W // GLA_HEADS
GLA_RANK = 16
GLA_TAU = 16.0
HG_HEADS = 4
HG_DK = 64
HG_DV = BRANCH_W // HG_HEADS
SSM_HEADS = 8
SSM_HEAD_DIM = BRANCH_W // SSM_HEADS
SSM_GROUPS = 2
SSM_STATE = 64
SSM_CONV = 4
SSM_INNER = SSM_HEADS * SSM_HEAD_DIM
SSM_CONV_CH = SSM_INNER + 2 * SSM_GROUPS * SSM_STATE
RET_HEADS = 4
RET_DK = 64
RET_DV = BRANCH_W // RET_HEADS
ROPE_BASE = 10000.0

SEG_WIDTHS = (
    GLA_HEADS * GLA_DK, GLA_HEADS * GLA_DK, BRANCH_W, GLA_RANK, BRANCH_W,
    HG_HEADS * HG_DK, HG_HEADS * HG_DK, BRANCH_W, BRANCH_W,
    BRANCH_W, SSM_CONV_CH, SSM_HEADS,
    RET_HEADS * RET_DK, RET_HEADS * RET_DK, BRANCH_W, BRANCH_W,
    N_BRANCH * D_MODEL,
)
N_IN = sum(SEG_WIDTHS)

kernel_name = 'hybrid_gla_hgrn2_ssd_retention_block'


def rms_norm(x, w):
    xf = x.astype(jnp.float32)
    y = xf * lax.rsqrt(jnp.mean(xf * xf, axis=-1, keepdims=True) + EPS)
    return (y * w.astype(jnp.float32)).astype(x.dtype)


def split_heads(t, n):
    b, s, _ = t.shape
    return t.reshape(b, s, n, -1).transpose(0, 2, 1, 3)


def merge_heads(t):
    b, h, s, d = t.shape
    return t.transpose(0, 2, 1, 3).reshape(b, s, h * d)


def split_columns(proj):
    idx = np.cumsum(SEG_WIDTHS)[:-1].tolist()
    return jnp.split(proj, idx, axis=-1)


def rotary_tables(s):
    inv = 1.0 / (ROPE_BASE ** (jnp.arange(0, RET_DK, 2, dtype=jnp.float32) / RET_DK))
    ang = jnp.arange(s, dtype=jnp.float32)[:, None] * inv[None, :]
    return jnp.cos(ang), jnp.sin(ang)


def apply_rotary(t, cos, sin):
    t1, t2 = jnp.split(t, 2, axis=-1)
    return jnp.concatenate([t1 * cos - t2 * sin, t1 * sin + t2 * cos], axis=-1)


def carry_chunk_states(local, decay):
    def step(state, inp):
        u, d = inp
        return d * state + u, state
    _, prev = lax.scan(step, jnp.zeros_like(local[0]), (local, decay))
    return prev


def gated_linear_attention(q, k, v, log_g):
    b, h, s, dk = q.shape
    dv = v.shape[-1]
    n = s // CHUNK

    def chunk_major(t):
        return t.reshape(b, h, n, CHUNK, t.shape[-1]).transpose(2, 0, 1, 3, 4)

    causal = jnp.tril(jnp.ones((CHUNK, CHUNK), dtype=bool))[:, :, None]

    def step(state, inp):
        qc, kc, vc, gc = inp
        cum = jnp.cumsum(gc.astype(jnp.float32), axis=2)
        rel = cum[:, :, :, None, :] - cum[:, :, None, :, :]
        decay = jnp.where(causal, jnp.exp(jnp.where(causal, rel, 0.0)), 0.0)
        scores = jnp.einsum('bhtk,bhsk,bhtsk->bhts', qc, kc, decay)
        o = (jnp.einsum('bhts,bhsv->bhtv', scores, vc)
             + jnp.einsum('bhtk,bhkv->bhtv', qc * jnp.exp(cum), state))
        last = cum[:, :, -1:, :]
        state = (jnp.exp(last[:, :, 0, :])[..., None] * state
                 + jnp.einsum('bhsk,bhsv->bhkv', kc * jnp.exp(last - cum), vc))
        return state, o

    init = jnp.zeros((b, h, dk, dv), jnp.float32)
    _, o = lax.scan(step, init, (chunk_major(q), chunk_major(k), chunk_major(v), chunk_major(log_g)))
    return o.transpose(1, 2, 0, 3, 4).reshape(b, h, s, dv)


def segsum_decay(a):
    t = a.shape[-1]
    strict = jnp.tril(jnp.ones((t, t), dtype=bool), -1)
    incl = jnp.tril(jnp.ones((t, t), dtype=bool))
    x = jnp.where(strict, jnp.broadcast_to(a[..., None], a.shape + (t,)), 0.0)
    ss = jnp.cumsum(x, axis=-2)
    return jnp.where(incl, jnp.exp(jnp.where(incl, ss, 0.0)), 0.0)


def causal_depthwise_conv(u, w, bias):
    out = lax.conv_general_dilated(
        u, w[:, None, :].astype(u.dtype), window_strides=(1,), padding=[(SSM_CONV - 1, 0)],
        dimension_numbers=('NWC', 'WIO', 'NWC'), feature_group_count=u.shape[-1])
    return out + bias.astype(out.dtype)


def gla_branch(q, k, v, lr, gate, w_lr, b_lr, norm_w):
    log_g = jax.nn.log_sigmoid((lr @ w_lr + b_lr).astype(jnp.float32)) / GLA_TAU
    o = gated_linear_attention(split_heads(q, GLA_HEADS) * GLA_DK ** -0.5, split_heads(k, GLA_HEADS),
                               split_heads(v, GLA_HEADS), split_heads(log_g, GLA_HEADS))
    return merge_heads(rms_norm(o, norm_w)) * jax.nn.silu(gate)


def hgrn2_branch(q, f, i, gate, lb, norm_w):
    lb = lb.astype(jnp.float32)
    ff = f.astype(jnp.float32)
    log_f = jnp.logaddexp(jax.nn.log_sigmoid(ff),
                          jnp.log(jnp.maximum(lb, LB_FLOOR)) + jax.nn.log_sigmoid(-ff))
    k = -jnp.expm1(log_f)
    o = gated_linear_attention(split_heads(q, HG_HEADS), split_heads(k, HG_HEADS),
                               split_heads(i, HG_HEADS), split_heads(log_f, HG_HEADS))
    return merge_heads(rms_norm(o, norm_w)) * jax.nn.silu(gate)


def mamba2_branch(z, xbc, dt, conv_w, conv_b, dt_bias, a_log, d_skip, norm_w):
    b, s, _ = xbc.shape
    n = s // CHUNK
    G, E, P, N = SSM_GROUPS, SSM_HEADS // SSM_GROUPS, SSM_HEAD_DIM, SSM_STATE
    xbc = jax.nn.silu(causal_depthwise_conv(xbc, conv_w, conv_b))
    xs, bm, cm = jnp.split(xbc, [SSM_INNER, SSM_INNER + G * N], axis=-1)
    dt = jax.nn.softplus(dt.astype(jnp.float32) + dt_bias.astype(jnp.float32))
    a = -jnp.exp(a_log.astype(jnp.float32))
    xh = xs.reshape(b, n, CHUNK, G, E, P)
    xdt = xh * dt.reshape(b, n, CHUNK, G, E)[..., None]
    bm = bm.reshape(b, n, CHUNK, G, N)
    cm = cm.reshape(b, n, CHUNK, G, N)
    a_dt = (dt * a).reshape(b, n, CHUNK, G, E).transpose(0, 3, 4, 1, 2)
    a_cum = jnp.cumsum(a_dt, axis=-1)
    L = segsum_decay(a_dt)
    y_diag = jnp.einsum('bnlgm,bnsgm,bgenls,bnsgep->bnlgep', cm, bm, L, xdt)
    decay_states = jnp.exp(a_cum[..., -1:] - a_cum)
    local = jnp.einsum('bnsgm,bgens,bnsgep->bngepm', bm, decay_states, xdt)
    chunk_decay = jnp.exp(a_cum[..., -1])
    prev = carry_chunk_states(jnp.moveaxis(local, 1, 0),
                              jnp.moveaxis(chunk_decay, 3, 0)[..., None, None])
    y_off = jnp.einsum('bnlgm,nbgepm,bgenl->bnlgep', cm, prev, jnp.exp(a_cum))
    y = y_diag + y_off + d_skip.reshape(G, E, 1) * xh
    y = y.reshape(b, s, SSM_INNER) * jax.nn.silu(z)
    y = rms_norm(y.reshape(b, s, G, SSM_INNER // G), norm_w.reshape(G, SSM_INNER // G))
    return y.reshape(b, s, SSM_INNER)


def chunk_retention(q, k, v, log_gamma):
    b, h, s, dk = q.shape
    dv = v.shape[-1]
    n = s // CHUNK
    qc = q.reshape(b, h, n, CHUNK, dk)
    kc = k.reshape(b, h, n, CHUNK, dk)
    vc = v.reshape(b, h, n, CHUNK, dv)
    idx = jnp.arange(CHUNK, dtype=jnp.float32)
    lg = log_gamma[:, None, None, None]
    dmat = jnp.exp(lg * jnp.abs(idx[:, None] - idx[None, :]))
    scores = jnp.einsum('bhntk,bhnsk->bhnts', qc, kc) * dmat
    o_intra = jnp.einsum('bhnts,bhnsv->bhntv', scores, vc)
    kdec = jnp.exp(lg * (CHUNK - 1 - idx)[None, None, :, None])
    local = jnp.einsum('bhnsk,bhnsv->bhnkv', kc * kdec, vc)
    cdec = jnp.broadcast_to(jnp.exp(log_gamma * CHUNK)[None, None, :, None, None], (n, 1, h, 1, 1))
    prev = jnp.moveaxis(carry_chunk_states(jnp.moveaxis(local, 2, 0), cdec), 0, 2)
    qdec = jnp.exp(lg * (idx + 1.0)[None, None, :, None])
    o_inter = jnp.einsum('bhntk,bhnkv->bhntv', qc * qdec, prev)
    return (o_intra + o_inter).reshape(b, h, s, dv)


def retention_branch(q, k, v, gate, cos, sin, log_gamma, norm_w):
    qh = apply_rotary(split_heads(q, RET_HEADS), cos, sin)
    kh = apply_rotary(split_heads(k, RET_HEADS), cos, sin) * RET_DK ** -0.5
    o = chunk_retention(qh, kh, split_heads(v, RET_HEADS), log_gamma)
    return merge_heads(rms_norm(o, norm_w)) * jax.nn.silu(gate)


def setup_inputs(seed: int = 0) -> dict:
    key = jax.random.key(seed)
    ks = jax.random.split(key, 20)
    f32 = jnp.float32

    def nrm(k, shape, scale):
        return jax.random.normal(k, shape, f32) * scale

    u = jax.random.uniform(ks[10], (DEPTH, SSM_HEADS), f32)
    dt0 = jnp.exp(u * (jnp.log(0.1) - jnp.log(0.001)) + jnp.log(0.001))
    return {
        'x': nrm(ks[0], (BATCH, SEQ, D_MODEL), 1.0),
        'norm_w': 1.0 + nrm(ks[1], (DEPTH, D_MODEL), 0.02),
        'w_in': nrm(ks[2], (DEPTH, D_MODEL, N_IN), D_MODEL ** -0.5),
        'gla_w_lr': nrm(ks[3], (DEPTH, GLA_RANK, GLA_HEADS * GLA_DK), GLA_RANK ** -0.5),
        'gla_b_lr': nrm(ks[4], (DEPTH, GLA_HEADS * GLA_DK), 0.1),
        'gla_norm': 1.0 + nrm(ks[5], (DEPTH, GLA_DV), 0.02),
        'hg_lb_logits': nrm(ks[6], (DEPTH, HG_HEADS * HG_DK), 0.5),
        'hg_norm': 1.0 + nrm(ks[7], (DEPTH, HG_DV), 0.02),
        'ssm_conv_w': nrm(ks[8], (DEPTH, SSM_CONV, SSM_CONV_CH), SSM_CONV ** -0.5),
        'ssm_conv_b': nrm(ks[9], (DEPTH, SSM_CONV_CH), 0.02),
        'ssm_dt_bias': dt0 + jnp.log(-jnp.expm1(-dt0)),
        'ssm_a_log': jnp.log(jax.random.uniform(ks[11], (DEPTH, SSM_HEADS), f32, 1.0, 16.0)),
        'ssm_d': 1.0 + nrm(ks[12], (DEPTH, SSM_HEADS), 0.02),
        'ssm_norm': 1.0 + nrm(ks[13], (DEPTH, SSM_INNER), 0.02),
        'ret_norm': 1.0 + nrm(ks[14], (DEPTH, RET_DV), 0.02),
        'w_up': nrm(ks[15], (DEPTH, N_BRANCH, BRANCH_W, D_MODEL), BRANCH_W ** -0.5),
        'w_out': nrm(ks[16], (DEPTH, D_MODEL, D_MODEL), D_MODEL ** -0.5),
        'final_norm': 1.0 + nrm(ks[17], (D_MODEL,), 0.02),
    }


def reference(x, norm_w, w_in, gla_w_lr, gla_b_lr, gla_norm, hg_lb_logits, hg_norm,
              ssm_conv_w, ssm_conv_b, ssm_dt_bias, ssm_a_log, ssm_d, ssm_norm,
              ret_norm, w_up, w_out, final_norm):
    b, s, _ = x.shape
    p = jax.nn.softmax(hg_lb_logits.astype(jnp.float32), axis=0)
    lower_bounds = jnp.cumsum(p, axis=0) - p
    cos, sin = rotary_tables(s)
    log_gamma = jnp.log(1.0 - 2.0 ** (-5.0 - jnp.arange(RET_HEADS, dtype=jnp.float32)))
    for l in range(DEPTH):
        h = rms_norm(x, norm_w[l])
        proj = h @ w_in[l]
        (gq, gk, gv, glr, gg, hq, hf, hi, hg, sz, sxbc, sdt, rq, rk, rv, rg, mg) = split_columns(proj)
        o_a = gla_branch(gq, gk, gv, glr, gg, gla_w_lr[l], gla_b_lr[l], gla_norm[l])
        o_b = hgrn2_branch(hq, hf, hi, hg, lower_bounds[l], hg_norm[l])
        o_c = mamba2_branch(sz, sxbc, sdt, ssm_conv_w[l], ssm_conv_b[l], ssm_dt_bias[l],
                            ssm_a_log[l], ssm_d[l], ssm_norm[l])
        o_d = retention_branch(rq, rk, rv, rg, cos, sin, log_gamma, ret_norm[l])
        outs = jnp.stack([o_a, o_b, o_c, o_d], axis=2).astype(h.dtype)
        up = jnp.einsum('bsnw,nwd->bsnd', outs, w_up[l])
        gates = jax.nn.sigmoid(mg.reshape(b, s, N_BRANCH, D_MODEL))
        merged = jnp.sum(gates * up, axis=2)
        x = x + (merged @ w_out[l]).astype(x.dtype)
    return rms_norm(x, final_norm)
```

```cpp
#include <hip/hip_runtime.h>
#ifndef EN_N
#define EN_N 1
#define EN_A 1
#define EN_B1 1
#define EN_B2 1
#define EN_B3 1
#define EN_C 1
#define EN_D 1
#endif
#include <cstdio>
#include <cstdint>

#ifndef MK_PER_PHASE_LAUNCH
#define MK_PER_PHASE_LAUNCH 0
#endif

#define LAS __attribute__((address_space(3)))
typedef unsigned short bf16_t;
typedef short bf16x8 __attribute__((ext_vector_type(8)));
typedef float f32x4 __attribute__((ext_vector_type(4)));
typedef unsigned u32x4 __attribute__((ext_vector_type(4)));
typedef unsigned u32x2 __attribute__((ext_vector_type(2)));

constexpr int D = 1024, BATCH = 8, SEQ = 4096, DEPTH = 4, NIN = 10008, NP = 10240;
constexpr int HBATCH = 4, MH = HBATCH * SEQ;
constexpr float EPS = 1e-6f;
constexpr int C_GQ = 0, C_GK = 256, C_GV = 512, C_GG = 1024, C_HQ = 1536, C_HF = 1792, C_HI = 2048, C_HG = 2560, C_SZ = 3072, C_SX = 3584,
              C_RQ = 4352, C_RK = 4608, C_RV = 4864, C_RG = 5376, C_LR = 5888, C_DT = 5904, C_MG = 6144;
__host__ __device__ __forceinline__ int origcol(int c) {
    if (c < 1024) return c;
    if (c < 4352) return c + 16;
    if (c < 5888) return c + 24;
    if (c < 5904) return c - 5888 + 1024;
    if (c < 5912) return c - 5904 + 4368;
    if (c < 6144) return -1;
    return c - 232;
}
enum { I_X = 0, I_NORMW, I_WIN, I_WLR, I_BLR, I_GNORM, I_HLB, I_HNORM, I_CONVW, I_CONVB, I_DTB, I_ALOG, I_SSMD, I_SNORM, I_RNORM, I_WUP, I_WOUT, I_FNORM };

constexpr size_t WS_CTL = 0, CTL_BYTES = 16384;
constexpr size_t WS_ROPE = 65536;
constexpr size_t WS_WIN = WS_ROPE + 2 * 4096 * 32 * 4;
constexpr size_t WS_WUP = WS_WIN + (size_t)NP * 1024 * 2;
constexpr size_t WS_WOUT = WS_WUP + (size_t)4 * 1024 * 512 * 2;
constexpr size_t WS_HB = WS_WOUT + (size_t)1024 * 1024 * 2;
constexpr size_t WS_PROJ = WS_HB + (size_t)MH * 1024 * 2;
constexpr size_t LOCAL_BR = (size_t)16 * 64 * 128 * 64 * 4;
constexpr size_t WS_LOCAL = WS_PROJ + (size_t)MH * NP * 2;
constexpr size_t STATE_BR = LOCAL_BR / 2;
constexpr size_t WS_STATE = WS_LOCAL + 4 * LOCAL_BR;
constexpr size_t DEC_BR = (size_t)32 * 64 * 64 * 4;
constexpr size_t WS_DEC = WS_STATE + 4 * STATE_BR;
constexpr size_t WS_END = WS_DEC + 4 * DEC_BR;

constexpr int LDS_BYTES = 147456;
constexpr int MISC_OFF = LDS_BYTES - 256;
constexpr int OFF_CUM = 0, OFF_SEG = 17408, OFF_QT = 19456, OFF_KT = 28672, OFF_AM = 37888, OFF_V = 55296, OFF_ST = 89088, OFF_O = 107520;
constexpr int LDV = 264;
constexpr int OFF_OML = 141312;

namespace pg8 {
constexpr int BM = 256, BK = 64, HALF = 128, HTB = HALF * BK * 2, STAGE_BYTES = 8 * HTB, NXCD = 8, WGM = 8;
__host__ __device__ __forceinline__ int lds_byte(int r, int c) { const int st = (r >> 4) * 2 + (c >> 5), rr = r & 15, cc = c & 31, ob = rr * 64 + cc * 2; return st * 1024 + (ob ^ (((ob >> 9) & 1) << 5)); }
__host__ __device__ __forceinline__ void stage_rc(int b, int& R, int& C) { const int st = b / 1024, sb = b % 1024, swz = sb ^ (((sb >> 9) & 1) << 5); R = (st >> 1) * 16 + swz / 64; C = (st & 1) * 32 + (swz % 64) / 2; }
__host__ __device__ __forceinline__ int perm32(int rho) { const int n = rho >> 4, i = rho & 15; return 8 * (i >> 2) + 4 * n + (i & 3); }
struct Unit { int pm, pn; };
struct Gemm { const bf16_t* A; const bf16_t* Bt; int M, N, K, lda, ldb; };
struct StaticOrder {
    int nM, nN, nwg, G, c;
    __host__ __device__ void init(int M, int N, int G_, int c_) { nM = M / BM; nN = N / BM; nwg = nM * nN; G = G_; c = c_; }
    __host__ __device__ bool next(int i, Unit& u) const {
        const long L = (long)i * G + c; if (L >= nwg) return false;
        int wgid = (int)L; { const int q = nwg / NXCD, r = nwg % NXCD, xcd = wgid % NXCD, off = wgid / NXCD; wgid = (xcd < r ? xcd * (q + 1) : r * (q + 1) + (xcd - r) * q) + off; }
        const int nig = WGM * nN, gid = wgid / nig, fm = gid * WGM, gsz = (nM - fm) < WGM ? (nM - fm) : WGM;
        u.pm = fm + ((wgid % nig) % gsz); u.pn = (wgid % nig) / gsz; return true;
    }
};
__device__ __forceinline__ unsigned cvt_pk_bf16(float lo, float hi) { unsigned r; asm volatile("v_cvt_pk_bf16_f32 %0, %1, %2" : "=v"(r) : "v"(lo), "v"(hi)); return r; }

struct EpiProj {
    static constexpr bool PERM = true;
    bf16_t* O;
    __device__ __forceinline__ void operator()(const f32x4 (&acc)[2][2][4][2], const Unit& u, int wr, int wc, int fr, int fq) const {
        const int row0 = u.pm * BM + wr * 64 + fr, col0 = u.pn * BM + wc * 32 + 8 * fq;
        const bool sig = u.pn >= 24;
#pragma unroll
        for (int ai = 0; ai < 2; ++ai)
#pragma unroll
            for (int m = 0; m < 4; ++m) { bf16_t* rowp = O + (size_t)(row0 + ai * HALF + m * 16) * NP + col0;
#pragma unroll
                for (int bj = 0; bj < 2; ++bj) { f32x4 v0 = acc[ai][bj][m][0], v1 = acc[ai][bj][m][1];
                    if (sig) {
#pragma unroll
                        for (int j = 0; j < 4; ++j) { v0[j] = __builtin_amdgcn_rcpf(1.0f + __expf(-v0[j])); v1[j] = __builtin_amdgcn_rcpf(1.0f + __expf(-v1[j])); } }
                    u32x4 w; w.x = cvt_pk_bf16(v0[0], v0[1]); w.y = cvt_pk_bf16(v0[2], v0[3]); w.z = cvt_pk_bf16(v1[0], v1[1]); w.w = cvt_pk_bf16(v1[2], v1[3]);
                    *(u32x4*)(rowp + bj * HALF) = w; } }
    }
};
struct EpiUp {
    static constexpr bool PERM = true;
    const bf16_t* G; bf16_t* Mg; int first;
    __device__ __forceinline__ void operator()(const f32x4 (&acc)[2][2][4][2], const Unit& u, int wr, int wc, int fr, int fq) const {
        const int row0 = u.pm * BM + wr * 64 + fr, col0 = u.pn * BM + wc * 32 + 8 * fq;
#pragma unroll
        for (int ai = 0; ai < 2; ++ai)
#pragma unroll
            for (int m = 0; m < 4; ++m) { const size_t r = (size_t)(row0 + ai * HALF + m * 16);
#pragma unroll
                for (int bj = 0; bj < 2; ++bj) { const int c = col0 + bj * HALF;
                    const u32x4 g = *(const u32x4*)(G + r * NP + c);
                    u32x4 o = (u32x4){0u, 0u, 0u, 0u}; if (!first) o = *(const u32x4*)(Mg + r * 1024 + c);
                    const f32x4 v0 = acc[ai][bj][m][0], v1 = acc[ai][bj][m][1];
                    float res[8];
#pragma unroll
                    for (int q = 0; q < 4; ++q) { const unsigned gw = g[q], ow = o[q];
                        const float g0 = __builtin_bit_cast(float, gw << 16), g1 = __builtin_bit_cast(float, gw & 0xffff0000u);
                        const float o0 = __builtin_bit_cast(float, ow << 16), o1 = __builtin_bit_cast(float, ow & 0xffff0000u);
                        const float a0 = (q < 2) ? v0[2 * q] : v1[2 * q - 4], a1 = (q < 2) ? v0[2 * q + 1] : v1[2 * q - 3];
                        res[2 * q] = g0 * a0 + o0; res[2 * q + 1] = g1 * a1 + o1; }
                    u32x4 w; w.x = cvt_pk_bf16(res[0], res[1]); w.y = cvt_pk_bf16(res[2], res[3]); w.z = cvt_pk_bf16(res[4], res[5]); w.w = cvt_pk_bf16(res[6], res[7]);
                    *(u32x4*)(Mg + r * 1024 + c) = w; } }
    }
};
struct EpiOut {
    static constexpr bool PERM = false;
    const float* Xin; float* Xout;
    __device__ __forceinline__ void operator()(const f32x4 (&acc)[2][2][4][2], const Unit& u, int wr, int wc, int fr, int fq) const {
        const int row0 = u.pm * BM + wr * 64 + fr, col0 = u.pn * BM + wc * 32 + 4 * fq;
#pragma unroll
        for (int ai = 0; ai < 2; ++ai)
#pragma unroll
            for (int m = 0; m < 4; ++m) { const size_t ro = (size_t)(row0 + ai * HALF + m * 16) * 1024 + col0;
#pragma unroll
                for (int bj = 0; bj < 2; ++bj)
#pragma unroll
                    for (int n = 0; n < 2; ++n) { const size_t o = ro + bj * HALF + n * 16; *(f32x4*)(Xout + o) = *(const f32x4*)(Xin + o) + acc[ai][bj][m][n]; } }
    }
};

template <class Epi, bool ALIGN_EPI>
__device__ __forceinline__ void gemm_phase(LAS unsigned char* lds, const Gemm g, const StaticOrder& S, const Epi& E, const int tid) {
    const int wid = __builtin_amdgcn_readfirstlane(tid >> 6), lane = tid & 63, wr = wid >> 2, wc = wid & 3, fr = lane & 15, fq = lane >> 4;
    const int K = g.K, nt = K / BK;
    unsigned voffA[2], voffB[2];
#pragma unroll
    for (int i = 0; i < 2; ++i) { int R, C; stage_rc(tid * 16 + i * 8192, R, C); const int Rb = Epi::PERM ? ((R & ~31) + perm32(R & 31)) : R;
        voffA[i] = (unsigned)(R * g.lda + C) * 2u; voffB[i] = (unsigned)(Rb * g.ldb + C) * 2u; }
    const size_t kstep = (size_t)(BK * 2);
    const size_t hstepA = (size_t)HALF * g.lda * 2, hstepB = (size_t)HALF * g.ldb * 2;
    const size_t tstepA = 2 * hstepA, tstepB = 2 * hstepB;
    const unsigned ldsw = (unsigned)wid * 1024u;
    const int aoff = lds_byte(wr * 64 + fr, fq * 8), boff = lds_byte(wc * 32 + fr, fq * 8);
#define PG8_SA(b, h) (((b) * 2 + (h)) * HTB)
#define PG8_SB(b, h) ((4 + (b) * 2 + (h)) * HTB)
#define PG8_STAGE(bufoff, gbase, voff) do { _Pragma("unroll") for (int _i = 0; _i < 2; ++_i) \
        __builtin_amdgcn_global_load_lds((const unsigned*)((const char*)(gbase) + (voff)[_i]), (LAS unsigned*)(lds + (bufoff) + ldsw + _i * 8192), 16, 0, 0); } while (0)
#define PG8_LDA(dst, b, h) do { _Pragma("unroll") for (int m = 0; m < 4; ++m) _Pragma("unroll") for (int k = 0; k < 2; ++k) dst[m][k] = *(const LAS bf16x8*)(lds + PG8_SA(b, h) + aoff + m * 2048 + k * 1024); } while (0)
#define PG8_LDB(dst, b, h) do { _Pragma("unroll") for (int n = 0; n < 2; ++n) _Pragma("unroll") for (int k = 0; k < 2; ++k) dst[n][k] = *(const LAS bf16x8*)(lds + PG8_SB(b, h) + boff + n * 2048 + k * 1024); } while (0)
#define PG8_MMA(ai, bj, At, Bt) do { __builtin_amdgcn_s_setprio(1); _Pragma("unroll") for (int m = 0; m < 4; ++m) _Pragma("unroll") for (int n = 0; n < 2; ++n) _Pragma("unroll") for (int k = 0; k < 2; ++k) \
        acc[ai][bj][m][n] = __builtin_amdgcn_mfma_f32_16x16x32_bf16(Bt[n][k], At[m][k], acc[ai][bj][m][n], 0, 0, 0); __builtin_amdgcn_s_setprio(0); } while (0)
#define PG8_WAIT_V(n) asm volatile("s_waitcnt vmcnt(" #n ")" ::: "memory")
#define PG8_WAIT_L(n) asm volatile("s_waitcnt lgkmcnt(" #n ")" ::: "memory")
#define PG8_BAR __builtin_amdgcn_s_barrier()
#define PG8_SCHED __builtin_amdgcn_sched_barrier(0)
    Unit cur, nxt; int ui = 0;
    if (!S.next(0, cur)) return;
    f32x4 acc[2][2][4][2];
#pragma unroll
    for (int a = 0; a < 2; ++a)
#pragma unroll
        for (int b = 0; b < 2; ++b)
#pragma unroll
            for (int m = 0; m < 4; ++m)
#pragma unroll
                for (int n = 0; n < 2; ++n) acc[a][b][m][n] = (f32x4){0.f, 0.f, 0.f, 0.f};
    bf16x8 At[4][2], B0[2][2], B1[2][2];
    const char* cA = (const char*)g.A + (size_t)cur.pm * tstepA; const char* cB = (const char*)g.Bt + (size_t)cur.pn * tstepB;
    PG8_STAGE(PG8_SB(0, 0), cB, voffB); PG8_STAGE(PG8_SB(0, 1), cB + hstepB, voffB); PG8_STAGE(PG8_SA(0, 0), cA, voffA); PG8_STAGE(PG8_SA(0, 1), cA + hstepA, voffA);
    if (wr == 1) PG8_BAR;
    PG8_WAIT_V(2); PG8_BAR;
    PG8_STAGE(PG8_SB(1, 0), cB + kstep, voffB); PG8_STAGE(PG8_SA(1, 0), cA + kstep, voffA); PG8_STAGE(PG8_SB(1, 1), cB + hstepB + kstep, voffB);
    PG8_WAIT_V(6); PG8_BAR;
    for (;;) {
        const bool has_next = S.next(ui + 1, nxt);
        const char* nA = has_next ? (const char*)g.A + (size_t)nxt.pm * tstepA : cA; const char* nB = has_next ? (const char*)g.Bt + (size_t)nxt.pn * tstepB : cB;
        for (int t = 0; t < nt; t += 2) {
            const bool last = (t == nt - 2);
            const char* a1 = cA + (size_t)(t + 1) * kstep;
            const char* a2 = last ? nA : cA + (size_t)(t + 2) * kstep; const char* b2 = last ? nB : cB + (size_t)(t + 2) * kstep;
            const char* a3 = a2 + kstep; const char* b3 = b2 + kstep;
            PG8_LDB(B0, 0, 0); PG8_LDB(B1, 0, 1); PG8_SCHED; PG8_LDA(At, 0, 0); PG8_STAGE(PG8_SA(1, 1), a1 + hstepA, voffA);
            PG8_WAIT_V(8); PG8_WAIT_L(0); PG8_BAR; PG8_MMA(0, 0, At, B0); PG8_MMA(0, 1, At, B1); PG8_BAR; PG8_SCHED;
            PG8_LDA(At, 0, 1); PG8_STAGE(PG8_SB(0, 0), b2, voffB); PG8_STAGE(PG8_SB(0, 1), b2 + hstepB, voffB); PG8_STAGE(PG8_SA(0, 0), a2, voffA);
            PG8_WAIT_V(8); PG8_WAIT_L(0); PG8_BAR; PG8_MMA(1, 0, At, B0); PG8_MMA(1, 1, At, B1); PG8_BAR; PG8_SCHED;
            PG8_LDB(B0, 1, 0); PG8_LDB(B1, 1, 1); PG8_SCHED; PG8_LDA(At, 1, 0); PG8_STAGE(PG8_SA(0, 1), a2 + hstepA, voffA);
            PG8_WAIT_V(8); PG8_WAIT_L(0); PG8_BAR; PG8_MMA(0, 0, At, B0); PG8_MMA(0, 1, At, B1); PG8_BAR; PG8_SCHED;
            PG8_LDA(At, 1, 1); PG8_STAGE(PG8_SB(1, 0), b3, voffB); PG8_STAGE(PG8_SB(1, 1), b3 + hstepB, voffB); PG8_STAGE(PG8_SA(1, 0), a3, voffA);
            PG8_WAIT_V(8); PG8_WAIT_L(0); PG8_BAR; PG8_MMA(1, 0, At, B0); PG8_MMA(1, 1, At, B1); PG8_BAR; PG8_SCHED;
        }
        if constexpr (ALIGN_EPI) { if (wr == 0) PG8_BAR; }
        E(acc, cur, wr, wc, fr, fq);
        if (!has_next) break;
#pragma unroll
        for (int a = 0; a < 2; ++a)
#pragma unroll
            for (int b = 0; b < 2; ++b)
#pragma unroll
                for (int m = 0; m < 4; ++m)
#pragma unroll
                    for (int n = 0; n < 2; ++n) acc[a][b][m][n] = (f32x4){0.f, 0.f, 0.f, 0.f};
        cur = nxt; cA = nA; cB = nB; ++ui;
        if constexpr (ALIGN_EPI) { if (wr == 1) PG8_BAR; }
    }
    PG8_WAIT_V(0);
    if constexpr (!ALIGN_EPI) { if (wr == 0) PG8_BAR; }
    PG8_BAR;
#undef PG8_SA
#undef PG8_SB
#undef PG8_STAGE
#undef PG8_LDA
#undef PG8_LDB
#undef PG8_MMA
#undef PG8_WAIT_V
#undef PG8_WAIT_L
#undef PG8_BAR
#undef PG8_SCHED
}
}

#define XB_TMO      128
#define XB_XCNT(j)  (256  + 64 * (j))
#define XB_XSUB(j)  (1280 + 64 * (j))
#define XB_XGEN(j)  (2304 + 64 * (j))
#define XB_TOP      3328
#define XB_TOPGEN   3392
#define XCD_BAR_WORDS 3456
#define XB_SPIN_CAP (1u << 18)
__device__ __forceinline__ unsigned xb_ld(unsigned* p)              { return __hip_atomic_load(p, __ATOMIC_RELAXED, __HIP_MEMORY_SCOPE_AGENT); }
__device__ __forceinline__ unsigned xb_add(unsigned* p, unsigned v) { return __hip_atomic_fetch_add(p, v, __ATOMIC_RELAXED, __HIP_MEMORY_SCOPE_AGENT); }
__device__ __forceinline__ unsigned xb_xcc_id() { return (unsigned)__builtin_amdgcn_s_getreg((3 << 11) | 20) & 0xFu; }
#define XB_SPIN(cond, bar) do { unsigned _sp = 0; while (cond) { __builtin_amdgcn_s_sleep(1); \
    if ((++_sp & 255u) == 0u) { if (xb_ld(&(bar)[XB_TMO])) break; if (_sp > XB_SPIN_CAP) { atomicAdd(&(bar)[XB_TMO], 1u); break; } } } } while (0)
struct XcdBarrier { unsigned* bar; unsigned x; volatile LAS unsigned* st; };
__device__ __forceinline__ XcdBarrier xcd_barrier_post(unsigned* bar, volatile LAS unsigned* st) {
    XcdBarrier b; b.bar = bar; b.x = xb_xcc_id(); b.st = st;
    if (threadIdx.x == 0) (void)xb_add(&bar[XB_XCNT(b.x)], 1u);
    return b;
}
__device__ __forceinline__ void xcd_barrier_complete(unsigned* bar, unsigned x, unsigned& nloc, unsigned& nx) {
    const unsigned G = gridDim.x * gridDim.y * gridDim.z;
    unsigned sum, cnt, mine, sp = 0u;
    for (;;) {
        sum = 0u; cnt = 0u;
        for (unsigned j = 0; j < 16; ++j) { const unsigned c = xb_ld(&bar[XB_XCNT(j)]); sum += c; cnt += (c > 0u) ? 1u : 0u; }
        mine = xb_ld(&bar[XB_XCNT(x)]);
        if (sum == G) break;
        __builtin_amdgcn_s_sleep(1);
        if ((++sp & 255u) == 0u) { if (xb_ld(&bar[XB_TMO])) break; if (sp > XB_SPIN_CAP) { atomicAdd(&bar[XB_TMO], 1u); break; } }
    }
    nloc = mine > 0u ? mine : 1u; nx = cnt > 0u ? cnt : 1u;
}
__device__ __forceinline__ void xcd_barrier(const XcdBarrier& b) {
    asm volatile("s_waitcnt vmcnt(0)" ::: "memory");
    __syncthreads();
    if (threadIdx.x == 0) {
        unsigned* bar = b.bar; asm volatile("" : "+s"(bar));
        __builtin_amdgcn_s_waitcnt(0);
        unsigned nloc = b.st[0], nx = b.st[1];
        if (nloc == 0u) { xcd_barrier_complete(bar, b.x, nloc, nx); b.st[0] = nloc; b.st[1] = nx; }
        const unsigned old = xb_add(&bar[XB_XSUB(b.x)], 1u);
        const unsigned gen = old / nloc;
        if (old + 1u == (gen + 1u) * nloc) {
            __builtin_amdgcn_fence(__ATOMIC_RELEASE, "agent");
            asm volatile("s_waitcnt vmcnt(0)" ::: "memory");
            const unsigned og = xb_add(&bar[XB_TOP], 1u);
            const unsigned tg = og / nx;
            if (og + 1u == (tg + 1u) * nx) xb_add(&bar[XB_TOPGEN], 1u);
            else XB_SPIN(xb_ld(&bar[XB_TOPGEN]) == tg, bar);
            __builtin_amdgcn_fence(__ATOMIC_ACQUIRE, "agent");
            xb_add(&bar[XB_XGEN(b.x)], 1u);
            asm volatile("s_waitcnt vmcnt(0)" ::: "memory");
        } else {
            XB_SPIN(xb_ld(&bar[XB_XGEN(b.x)]) == gen, bar);
            __builtin_amdgcn_fence(__ATOMIC_ACQUIRE, "agent");
            asm volatile("s_waitcnt vmcnt(0)" ::: "memory");
        }
    }
    __syncthreads();
}

#define LDS_WAIT() asm volatile("s_waitcnt lgkmcnt(0)" ::: "memory")
__device__ __forceinline__ float bf2f(unsigned short h) { return __builtin_bit_cast(float, (unsigned)h << 16); }
__device__ __forceinline__ float bflo(unsigned w) { return __builtin_bit_cast(float, w << 16); }
__device__ __forceinline__ float bfhi(unsigned w) { return __builtin_bit_cast(float, w & 0xffff0000u); }
__device__ __forceinline__ unsigned pk2(float lo, float hi) { return pg8::cvt_pk_bf16(lo, hi); }
__device__ __forceinline__ void unpack8(const u32x4 w, float (&f)[8]) {
#pragma unroll
    for (int q = 0; q < 4; ++q) { f[2 * q] = bflo(w[q]); f[2 * q + 1] = bfhi(w[q]); }
}
__device__ __forceinline__ u32x4 pack8(const float (&f)[8]) { u32x4 w; w.x = pk2(f[0], f[1]); w.y = pk2(f[2], f[3]); w.z = pk2(f[4], f[5]); w.w = pk2(f[6], f[7]); return w; }
__device__ __forceinline__ float wave_sum(float v) {
#pragma unroll
    for (int o = 1; o < 64; o <<= 1) v += __shfl_xor(v, o);
    return v;
}
__device__ __forceinline__ float logsig(float x) { return fminf(x, 0.f) - log1pf(expf(-fabsf(x))); }
__device__ __forceinline__ float softplusf_(float x) { return fmaxf(x, 0.f) + log1pf(expf(-fabsf(x))); }
__device__ __forceinline__ float siluf_(float x) { return x / (1.0f + __expf(-x)); }
__device__ __forceinline__ float clampf_(float x, float lo, float hi) { return fminf(fmaxf(x, lo), hi); }

__device__ const double ROPE_INV_TURNS[32] = {
    1.59154943091895346e-01, 1.19349369005342654e-01, 8.94994027620097804e-02, 6.71150846704077902e-02, 5.03292117661844479e-02, 3.77415881547067678e-02, 2.83021955739452893e-02, 2.12236531366118003e-02,
    1.59154945463488816e-02, 1.19349361890562274e-02, 8.94993956472293906e-03, 6.71150811130175919e-03, 5.03292153235746463e-03, 3.77415828186214788e-03, 2.83021961668436560e-03, 2.12236537295101661e-03,
    1.59154939534505145e-03, 1.19349373748529582e-03, 8.94994015762130509e-04, 6.71150796307716838e-04, 5.03292153235746485e-04, 3.77415865242362598e-04, 2.83021961668436560e-04, 2.12236529883872083e-04,
    1.59154950651349498e-04, 1.19349366337300012e-04, 8.94993978705982618e-05, 6.71150898212123409e-05, 5.03292153235746431e-05, 3.77415869874381108e-05, 2.83021957036418071e-05, 2.12236539147909035e-05};

struct Args { const float* in[18]; float* out; unsigned char* ws; int ph_lo, ph_hi, single, pad; };
struct KA {
    LAS unsigned char* lds;
    __device__ __forceinline__ unsigned long long ld(int i) const { volatile LAS unsigned* p = (volatile LAS unsigned*)(lds + MISC_OFF + 64) + 2 * i;
        const unsigned lo = __builtin_amdgcn_readfirstlane(p[0]), hi = __builtin_amdgcn_readfirstlane(p[1]); return ((unsigned long long)hi << 32) | lo; }
    __device__ __forceinline__ const float* in(int i) const { return (const float*)ld(i); }
    __device__ __forceinline__ float* out() const { return (float*)ld(18); }
    __device__ __forceinline__ unsigned char* ws() const { return (unsigned char*)ld(19); }
};

__device__ __forceinline__ bf16x8 frag_kc(const LAS bf16_t* X, int ld, int idx0, int k0, int lane) {
    return *(const LAS bf16x8*)(X + (idx0 + (lane & 15)) * ld + k0 + 8 * (lane >> 4));
}
__device__ __forceinline__ bf16x8 frag_ks(const LAS bf16_t* X, int ld, int idx0, int k0, int lane) {
    const LAS bf16_t* p = X + (k0 + 8 * (lane >> 4)) * ld + idx0 + (lane & 15);
    bf16x8 r;
#pragma unroll
    for (int i = 0; i < 8; ++i) r[i] = (short)p[i * ld];
    return r;
}
template <int MT, int NT, int KS, class FA, class FB, class EP>
__device__ __forceinline__ void tile_mm(int wave, int lane, FA&& fa, FB&& fb, EP&& epi) {
    for (int tix = wave; tix < MT * NT; tix += 8) {
        const int mt = tix % MT, nt = tix / MT;
        f32x4 acc = (f32x4){0.f, 0.f, 0.f, 0.f};
#pragma unroll
        for (int ks = 0; ks < KS; ++ks) { const bf16x8 av = fa(mt * 16, ks), bv = fb(nt * 16, ks); acc = __builtin_amdgcn_mfma_f32_16x16x32_bf16(bv, av, acc, 0, 0, 0); }
        epi(mt * 16 + (lane & 15), nt * 16 + 4 * (lane >> 4), acc);
    }
}

template <bool MAP>
__device__ __forceinline__ void transpose_item(const float* W, int K, int ldw, bf16_t* WT, LAS float* scr, int kb, int nb, int lane) {
    const int k0 = 64 * kb, n0 = 32 * nb;
    int nsrc = n0 + (lane & 31); if (MAP) nsrc = origcol(nsrc);
#pragma unroll 8
    for (int i = 0; i < 32; ++i) { const int kk = 2 * i + (lane >> 5); scr[kk * 33 + (lane & 31)] = (nsrc >= 0) ? W[(size_t)(k0 + kk) * ldw + nsrc] : 0.f; }
    LDS_WAIT(); asm volatile("" ::: "memory");
    const int c = lane & 7;
#pragma unroll
    for (int j = 0; j < 4; ++j) { const int n = (lane >> 3) + 8 * j; const LAS float* s = scr + (8 * c) * 33 + n;
        u32x4 o; o.x = pk2(s[0 * 33], s[1 * 33]); o.y = pk2(s[2 * 33], s[3 * 33]); o.z = pk2(s[4 * 33], s[5 * 33]); o.w = pk2(s[6 * 33], s[7 * 33]);
        *(u32x4*)(WT + (size_t)(n0 + n) * K + k0 + 8 * c) = o; }
    LDS_WAIT(); asm volatile("" ::: "memory");
}
__device__ __forceinline__ void phase_weights(const KA a, LAS unsigned char* lds, int l, int gw, int ngw, int wave, int lane) {
    LAS float* scr = (LAS float*)(lds + wave * 8448);
    constexpr int I_IN = 16 * (NP / 32), I_UP1 = 8 * 32, I_OUT = 16 * 32;
    constexpr int NITEMS = I_IN + 4 * I_UP1 + I_OUT;
    for (int it = gw; it < NITEMS; it += ngw) {
        int r = it;
        if (r < I_IN) { transpose_item<true>(a.in(I_WIN) + (size_t)l * 1024 * NIN, 1024, NIN, (bf16_t*)(a.ws() + WS_WIN), scr, r / (NP / 32), r % (NP / 32), lane); continue; } r -= I_IN;
        if (r < 4 * I_UP1) { const int n = r / I_UP1; r %= I_UP1;
            transpose_item<false>(a.in(I_WUP) + ((size_t)l * 4 + n) * 512 * 1024, 512, 1024, (bf16_t*)(a.ws() + WS_WUP) + (size_t)n * 1024 * 512, scr, r / 32, r % 32, lane); continue; } r -= 4 * I_UP1;
        transpose_item<false>(a.in(I_WOUT) + (size_t)l * 1024 * 1024, 1024, 1024, (bf16_t*)(a.ws() + WS_WOUT), scr, r / 32, r % 32, lane);
    }
}
__device__ __forceinline__ void phase_rope(const KA a, int gtid, int nthr) {
    float* ct = (float*)(a.ws() + WS_ROPE); float* st = ct + 4096 * 32;
    for (int idx = gtid; idx < 4096 * 32; idx += nthr) { const int pos = idx >> 5, j = idx & 31;
        const double t = (double)pos * ROPE_INV_TURNS[j]; const float fr = (float)(t - floor(t));
        ct[idx] = __builtin_amdgcn_cosf(fr); st[idx] = __builtin_amdgcn_sinf(fr); }
}
__device__ __forceinline__ void phase_norm(const float* xsrc, const float* w, bf16_t* hb, int nrows, int gw, int ngw, int lane) {
    f32x4 wv[4];
#pragma unroll
    for (int j = 0; j < 4; ++j) wv[j] = ((const f32x4*)w)[lane + 64 * j];
    for (int m = gw; m < nrows; m += ngw) {
        const f32x4* xr = (const f32x4*)(xsrc + (size_t)m * D) + lane;
        f32x4 v[4]; float ss = 0.f;
#pragma unroll
        for (int j = 0; j < 4; ++j) { v[j] = xr[64 * j]; ss += (v[j].x * v[j].x + v[j].y * v[j].y) + (v[j].z * v[j].z + v[j].w * v[j].w); }
        const float r = 1.0f / sqrtf(wave_sum(ss) * (1.0f / D) + EPS);
        u32x2* o8 = (u32x2*)(hb + (size_t)m * D) + lane;
#pragma unroll
        for (int j = 0; j < 4; ++j) { u32x2 o; o.x = pk2(v[j].x * r * wv[j].x, v[j].y * r * wv[j].y); o.y = pk2(v[j].z * r * wv[j].z, v[j].w * r * wv[j].w); o8[64 * j] = o; }
    }
}
__device__ __forceinline__ void phase_final(float* x, const float* w, int nrows, int gw, int ngw, int lane) {
    f32x4 wv[4];
#pragma unroll
    for (int j = 0; j < 4; ++j) wv[j] = ((const f32x4*)w)[lane + 64 * j];
    for (int m = gw; m < nrows; m += ngw) {
        f32x4* xr = (f32x4*)(x + (size_t)m * D) + lane;
        f32x4 v[4]; float ss = 0.f;
#pragma unroll
        for (int j = 0; j < 4; ++j) { v[j] = xr[64 * j]; ss += (v[j].x * v[j].x + v[j].y * v[j].y) + (v[j].z * v[j].z + v[j].w * v[j].w); }
        const float r = 1.0f / sqrtf(wave_sum(ss) * (1.0f / D) + EPS);
#pragma unroll
        for (int j = 0; j < 4; ++j) xr[64 * j] = v[j] * r * wv[j];
    }
}

__device__ __forceinline__ void out128_tail(LAS unsigned char* lds, bf16_t* P, int colg, const float* nw, int tid) {
    const int lane = tid & 63, wave = __builtin_amdgcn_readfirstlane(tid >> 6);
    const LAS bf16_t* AM = (const LAS bf16_t*)(lds + OFF_AM); const LAS bf16_t* V = (const LAS bf16_t*)(lds + OFF_V); const LAS bf16_t* ST = (const LAS bf16_t*)(lds + OFF_ST);
    LAS float* O = (LAS float*)(lds + OFF_O);
    tile_mm<4, 8, 4>(wave, lane,
        [&](int m0, int ks) { return frag_kc(AM, 136, m0, ks * 32, lane); },
        [&](int n0, int ks) { return ks < 2 ? frag_ks(V, LDV, n0, ks * 32, lane) : frag_kc(ST, 72, n0, (ks - 2) * 32, lane); },
        [&](int t, int v0, const f32x4& acc) { *(LAS f32x4*)(O + t * 132 + v0) = acc; });
    __syncthreads();
    const int t = tid >> 3, sub = tid & 7;
    f32x4 o[4]; float ss = 0.f;
#pragma unroll
    for (int j = 0; j < 4; ++j) { o[j] = *(const LAS f32x4*)(O + t * 132 + sub * 16 + 4 * j); ss += (o[j].x * o[j].x + o[j].y * o[j].y) + (o[j].z * o[j].z + o[j].w * o[j].w); }
    ss += __shfl_xor(ss, 1); ss += __shfl_xor(ss, 2); ss += __shfl_xor(ss, 4);
    const float r = 1.0f / sqrtf(ss * (1.0f / 128.0f) + EPS);
    bf16_t* gp = P + (size_t)t * NP + colg + sub * 16;
#pragma unroll
    for (int hh = 0; hh < 2; ++hh) {
        const u32x4 gw = *(const u32x4*)(gp + 8 * hh); float g[8]; unpack8(gw, g);
        const f32x4 w0 = *(const f32x4*)(nw + sub * 16 + 8 * hh), w1 = *(const f32x4*)(nw + sub * 16 + 8 * hh + 4);
        float res[8];
#pragma unroll
        for (int i = 0; i < 4; ++i) { res[i] = o[2 * hh][i] * r * w0[i] * siluf_(g[i]); res[4 + i] = o[2 * hh + 1][i] * r * w1[i] * siluf_(g[4 + i]); }
        *(u32x4*)(gp + 8 * hh) = pack8(res);
    }
    __syncthreads();
}
__device__ __forceinline__ void local128_tail(LAS unsigned char* lds, float* loc, int tid) {
    const int lane = tid & 63, wave = __builtin_amdgcn_readfirstlane(tid >> 6);
    const LAS bf16_t* V = (const LAS bf16_t*)(lds + OFF_V); const LAS bf16_t* KT = (const LAS bf16_t*)(lds + OFF_KT);
    tile_mm<8, 4, 2>(wave, lane,
        [&](int m0, int ks) { return frag_ks(V, LDV, m0, ks * 32, lane); },
        [&](int n0, int ks) { return frag_ks(KT, 72, n0, ks * 32, lane); },
        [&](int v, int k0, const f32x4& acc) { *(f32x4*)(loc + (size_t)v * 64 + k0) = acc; });
}
template <int PH>
__device__ __forceinline__ void load_v_st(LAS unsigned char* lds, const bf16_t* P, int colv, const bf16_t* S, int tid) {
    LAS bf16_t* V = (LAS bf16_t*)(lds + OFF_V); LAS bf16_t* ST = (LAS bf16_t*)(lds + OFF_ST);
#pragma unroll
    for (int j = 0; j < 2; ++j) { const int id = tid + 512 * j, tt = id >> 4, v8 = (id & 15) * 8; *(LAS u32x4*)(V + tt * LDV + v8) = *(const u32x4*)(P + (size_t)tt * NP + colv + v8); }
    if (PH == 3) {
#pragma unroll
        for (int j = 0; j < 2; ++j) { const int id = tid + 512 * j, vv = id >> 3, kq = (id & 7) * 8; *(LAS u32x4*)(ST + vv * 72 + kq) = *(const u32x4*)(S + vv * 64 + kq); }
    }
}

template <int BR, int PH>
__device__ __forceinline__ void unit_gl(const KA a, LAS unsigned char* lds, int l, int bl, int h, int c, int tid) {
    const int lane = tid & 63, wave = __builtin_amdgcn_readfirstlane(tid >> 6);
    bf16_t* P = (bf16_t*)(a.ws() + WS_PROJ) + (size_t)(bl * SEQ + c * 64) * NP;
    LAS float* CUM = (LAS float*)(lds + OFF_CUM); LAS float* SEG = (LAS float*)(lds + OFF_SEG);
    LAS bf16_t* QT = (LAS bf16_t*)(lds + OFF_QT); LAS bf16_t* KT = (LAS bf16_t*)(lds + OFF_KT); LAS bf16_t* AM = (LAS bf16_t*)(lds + OFF_AM);
    constexpr int CQ = BR == 0 ? C_GQ : C_HQ, CK = BR == 0 ? C_GK : C_HF, CV = BR == 0 ? C_GV : C_HI, CG = BR == 0 ? C_GG : C_HG;
    const int bh = bl * 4 + h;
    const int k = lane;
    float lgv[8];
    if (BR == 0) {
        LAS float* LRS = (LAS float*)(lds + OFF_O); LAS float* WLR = LRS + 64 * 17;
        if (tid < 128) { const int t = tid >> 1, h8 = (tid & 1) * 8; const u32x4 w = *(const u32x4*)(P + (size_t)t * NP + C_LR + h8); float f[8]; unpack8(w, f);
#pragma unroll
            for (int i = 0; i < 8; ++i) LRS[t * 17 + h8 + i] = f[i]; }
        for (int idx = tid; idx < 1024; idx += 512) WLR[idx] = a.in(I_WLR)[(size_t)l * 16 * 256 + (idx >> 6) * 256 + h * 64 + (idx & 63)];
        __syncthreads();
        const float bk = a.in(I_BLR)[l * 256 + h * 64 + k];
#pragma unroll
        for (int i = 0; i < 8; ++i) { const int t = wave * 8 + i; float x = bk;
#pragma unroll
            for (int r = 0; r < 16; ++r) x += LRS[t * 17 + r] * WLR[r * 64 + k];
            lgv[i] = logsig(x) * (1.0f / 16.0f); }
    } else {
        const float* lg = a.in(I_HLB); const int ch = h * 64 + k;
        const float x0 = lg[ch], x1 = lg[256 + ch], x2 = lg[512 + ch], x3 = lg[768 + ch];
        const float mx = fmaxf(fmaxf(x0, x1), fmaxf(x2, x3));
        const float e0 = expf(x0 - mx), e1 = expf(x1 - mx), e2 = expf(x2 - mx), e3 = expf(x3 - mx), inv = 1.0f / (e0 + e1 + e2 + e3);
        float lb = 0.f; if (l > 0) lb += e0 * inv; if (l > 1) lb += e1 * inv; if (l > 2) lb += e2 * inv;
        const float lbm = fmaxf(lb, 1e-30f), loglb = logf(lbm);
        if (wave == 0) ((LAS float*)(lds + OFF_OML))[k] = 1.0f - lbm;
#pragma unroll
        for (int i = 0; i < 8; ++i) { const int t = wave * 8 + i; const float z = bf2f(P[(size_t)t * NP + CK + h * 64 + k]);
            const float a1 = logsig(z), a2 = loglb + logsig(-z); lgv[i] = fmaxf(a1, a2) + log1pf(expf(-fabsf(a1 - a2))); }
    }
#pragma unroll
    for (int i = 1; i < 8; ++i) lgv[i] += lgv[i - 1];
#pragma unroll
    for (int i = 0; i < 8; ++i) CUM[(wave * 8 + i) * 68 + k] = lgv[i];
    SEG[wave * 64 + k] = lgv[7];
    __syncthreads();
    float pre = 0.f;
    for (int w = 0; w < wave; ++w) pre += SEG[w * 64 + k];
#pragma unroll
    for (int i = 0; i < 8; ++i) CUM[(wave * 8 + i) * 68 + k] = lgv[i] + pre;
    __syncthreads();
    {
        const int t = tid >> 3, k8 = (tid & 7) * 8;
        float kk[8]; { const u32x4 kw = *(const u32x4*)(P + (size_t)t * NP + CK + h * 64 + k8); unpack8(kw, kk); }
        if (BR == 1) {
#pragma unroll
            for (int i = 0; i < 8; ++i) kk[i] = ((const LAS float*)(lds + OFF_OML))[k8 + i] / (1.0f + __expf(kk[i]));
        }
        float ct[8];
#pragma unroll
        for (int i = 0; i < 8; ++i) ct[i] = CUM[t * 68 + k8 + i];
        if (PH == 3) {
            float q[8]; { const u32x4 qw = *(const u32x4*)(P + (size_t)t * NP + CQ + h * 64 + k8); unpack8(qw, q); }
            const float qs = (BR == 0) ? 0.125f : 1.0f;
            float qt[8], kt[8], qh[8];
#pragma unroll
            for (int i = 0; i < 8; ++i) { const float d = clampf_(ct[i] - CUM[31 * 68 + k8 + i], -80.f, 80.f);
                qt[i] = q[i] * qs * __expf(d); kt[i] = kk[i] * __expf(-d); qh[i] = q[i] * qs * __expf(ct[i]); }
            *(LAS u32x4*)(QT + t * 72 + k8) = pack8(qt); *(LAS u32x4*)(KT + t * 72 + k8) = pack8(kt); *(LAS u32x4*)(AM + t * 136 + 64 + k8) = pack8(qh);
        } else {
            float kb[8];
#pragma unroll
            for (int i = 0; i < 8; ++i) kb[i] = kk[i] * __expf(CUM[63 * 68 + k8 + i] - ct[i]);
            *(LAS u32x4*)(KT + t * 72 + k8) = pack8(kb);
        }
    }
    load_v_st<PH>(lds, P, CV + h * 128, (const bf16_t*)(a.ws() + WS_STATE + BR * STATE_BR) + (size_t)(bh * 64 + c) * 8192, tid);
    __syncthreads();
    if (PH == 3) {
        tile_mm<4, 4, 2>(wave, lane,
            [&](int m0, int ks) { return frag_kc(QT, 72, m0, ks * 32, lane); },
            [&](int n0, int ks) { return frag_kc(KT, 72, n0, ks * 32, lane); },
            [&](int t, int s0, const f32x4& acc) { u32x2 w; w.x = pk2(s0 <= t ? acc[0] : 0.f, s0 + 1 <= t ? acc[1] : 0.f); w.y = pk2(s0 + 2 <= t ? acc[2] : 0.f, s0 + 3 <= t ? acc[3] : 0.f);
                *(LAS u32x2*)(AM + t * 136 + s0) = w; });
        __syncthreads();
        out128_tail(lds, P, CG + h * 128, a.in(BR == 0 ? I_GNORM : I_HNORM) + l * 128, tid);
    } else {
        local128_tail(lds, (float*)(a.ws() + WS_LOCAL + BR * LOCAL_BR) + (size_t)(bh * 64 + c) * 8192, tid);
        if (tid < 64) ((float*)(a.ws() + WS_DEC + BR * DEC_BR))[(size_t)(bh * 64 + c) * 64 + tid] = __expf(CUM[63 * 68 + tid]);
        __syncthreads();
    }
}

template <int PH>
__device__ __forceinline__ void unit_ret(const KA a, LAS unsigned char* lds, int l, int bl, int h, int c, int tid) {
    const int lane = tid & 63, wave = __builtin_amdgcn_readfirstlane(tid >> 6);
    bf16_t* P = (bf16_t*)(a.ws() + WS_PROJ) + (size_t)(bl * SEQ + c * 64) * NP;
    LAS bf16_t* QT = (LAS bf16_t*)(lds + OFF_QT); LAS bf16_t* KT = (LAS bf16_t*)(lds + OFF_KT); LAS bf16_t* AM = (LAS bf16_t*)(lds + OFF_AM);
    const int bh = bl * 4 + h;
    const float lg = logf(1.0f - exp2f(-5.0f - (float)h));
    {
        const int t = tid >> 3, j4 = (tid & 7) * 4, pos = c * 64 + t;
        const float* ctab = (const float*)(a.ws() + WS_ROPE); const float* stab = ctab + 4096 * 32;
        const f32x4 cs = *(const f32x4*)(ctab + pos * 32 + j4), sn = *(const f32x4*)(stab + pos * 32 + j4);
        const u32x2 k1w = *(const u32x2*)(P + (size_t)t * NP + C_RK + h * 64 + j4), k2w = *(const u32x2*)(P + (size_t)t * NP + C_RK + h * 64 + 32 + j4);
        const float k1[4] = {bflo(k1w.x), bfhi(k1w.x), bflo(k1w.y), bfhi(k1w.y)}, k2[4] = {bflo(k2w.x), bfhi(k2w.x), bflo(k2w.y), bfhi(k2w.y)};
        float ka[4], kb[4];
#pragma unroll
        for (int i = 0; i < 4; ++i) { ka[i] = (k1[i] * cs[i] - k2[i] * sn[i]) * 0.125f; kb[i] = (k1[i] * sn[i] + k2[i] * cs[i]) * 0.125f; }
        if (PH == 3) {
            const u32x2 q1w = *(const u32x2*)(P + (size_t)t * NP + C_RQ + h * 64 + j4), q2w = *(const u32x2*)(P + (size_t)t * NP + C_RQ + h * 64 + 32 + j4);
            const float q1[4] = {bflo(q1w.x), bfhi(q1w.x), bflo(q1w.y), bfhi(q1w.y)}, q2[4] = {bflo(q2w.x), bfhi(q2w.x), bflo(q2w.y), bfhi(q2w.y)};
            float qa[4], qb[4];
#pragma unroll
            for (int i = 0; i < 4; ++i) { qa[i] = q1[i] * cs[i] - q2[i] * sn[i]; qb[i] = q1[i] * sn[i] + q2[i] * cs[i]; }
            const float gq = __expf(lg * (float)(t + 1));
            u32x2 w;
            w.x = pk2(qa[0], qa[1]); w.y = pk2(qa[2], qa[3]); *(LAS u32x2*)(QT + t * 72 + j4) = w;
            w.x = pk2(qb[0], qb[1]); w.y = pk2(qb[2], qb[3]); *(LAS u32x2*)(QT + t * 72 + 32 + j4) = w;
            w.x = pk2(ka[0], ka[1]); w.y = pk2(ka[2], ka[3]); *(LAS u32x2*)(KT + t * 72 + j4) = w;
            w.x = pk2(kb[0], kb[1]); w.y = pk2(kb[2], kb[3]); *(LAS u32x2*)(KT + t * 72 + 32 + j4) = w;
            w.x = pk2(qa[0] * gq, qa[1] * gq); w.y = pk2(qa[2] * gq, qa[3] * gq); *(LAS u32x2*)(AM + t * 136 + 64 + j4) = w;
            w.x = pk2(qb[0] * gq, qb[1] * gq); w.y = pk2(qb[2] * gq, qb[3] * gq); *(LAS u32x2*)(AM + t * 136 + 96 + j4) = w;
        } else {
            const float gk = __expf(lg * (float)(63 - t));
            u32x2 w;
            w.x = pk2(ka[0] * gk, ka[1] * gk); w.y = pk2(ka[2] * gk, ka[3] * gk); *(LAS u32x2*)(KT + t * 72 + j4) = w;
            w.x = pk2(kb[0] * gk, kb[1] * gk); w.y = pk2(kb[2] * gk, kb[3] * gk); *(LAS u32x2*)(KT + t * 72 + 32 + j4) = w;
        }
    }
    load_v_st<PH>(lds, P, C_RV + h * 128, (const bf16_t*)(a.ws() + WS_STATE + 2 * STATE_BR) + (size_t)(bh * 64 + c) * 8192, tid);
    __syncthreads();
    if (PH == 3) {
        tile_mm<4, 4, 2>(wave, lane,
            [&](int m0, int ks) { return frag_kc(QT, 72, m0, ks * 32, lane); },
            [&](int n0, int ks) { return frag_kc(KT, 72, n0, ks * 32, lane); },
            [&](int t, int s0, const f32x4& acc) { float r[4];
#pragma unroll
                for (int j = 0; j < 4; ++j) r[j] = acc[j] * __expf(lg * fabsf((float)(t - s0 - j)));
                u32x2 w; w.x = pk2(r[0], r[1]); w.y = pk2(r[2], r[3]); *(LAS u32x2*)(AM + t * 136 + s0) = w; });
        __syncthreads();
        out128_tail(lds, P, C_RG + h * 128, a.in(I_RNORM) + l * 128, tid);
    } else {
        local128_tail(lds, (float*)(a.ws() + WS_LOCAL + 2 * LOCAL_BR) + (size_t)(bh * 64 + c) * 8192, tid);
        if (tid < 64) ((float*)(a.ws() + WS_DEC + 2 * DEC_BR))[(size_t)(bh * 64 + c) * 64 + tid] = __expf(64.0f * lg);
        __syncthreads();
    }
}

template <int PH>
__device__ __forceinline__ void unit_mamba(const KA a, LAS unsigned char* lds, int l, int bl, int g, int c, int tid) {
    const int lane = tid & 63, wave = __builtin_amdgcn_readfirstlane(tid >> 6);
    bf16_t* PB = (bf16_t*)(a.ws() + WS_PROJ);
    bf16_t* P = PB + (size_t)(bl * SEQ + c * 64) * NP;
    LAS float* DT = (LAS float*)(lds + OFF_SEG); LAS float* CH = DT + 256;
    LAS bf16_t* QT = (LAS bf16_t*)(lds + OFF_QT); LAS bf16_t* KT = (LAS bf16_t*)(lds + OFF_KT); LAS bf16_t* AM = (LAS bf16_t*)(lds + OFF_AM);
    LAS bf16_t* V = (LAS bf16_t*)(lds + OFF_V); LAS bf16_t* ST = (LAS bf16_t*)(lds + OFF_ST);
    if (tid < 256) {
        const int hh = g * 4 + wave;
        const float raw = bf2f(P[(size_t)lane * NP + C_DT + hh]);
        const float dt = softplusf_(raw + a.in(I_DTB)[l * 8 + hh]);
        float x = -expf(a.in(I_ALOG)[l * 8 + hh]) * dt;
#pragma unroll
        for (int off = 1; off < 64; off <<= 1) { const float y = __shfl_up(x, off); if (lane >= off) x += y; }
        DT[wave * 64 + lane] = dt; CH[wave * 64 + lane] = x;
    }
    __syncthreads();
    for (int j = 0; j < 6; ++j) {
        const int id = tid + 512 * j, t = id / 48, c8 = id % 48;
        const int ch = (c8 < 32) ? (g * 256 + c8 * 8) : (c8 < 40) ? (512 + g * 64 + (c8 - 32) * 8) : (640 + g * 64 + (c8 - 40) * 8);
        float acc[8];
        { const f32x4 b0 = *(const f32x4*)(a.in(I_CONVB) + l * 768 + ch), b1 = *(const f32x4*)(a.in(I_CONVB) + l * 768 + ch + 4);
#pragma unroll
          for (int i = 0; i < 4; ++i) { acc[i] = b0[i]; acc[4 + i] = b1[i]; } }
#pragma unroll
        for (int w = 0; w < 4; ++w) { const int pos = c * 64 + t - 3 + w;
            if (pos >= 0) { const u32x4 xw = *(const u32x4*)(PB + (size_t)(bl * SEQ + pos) * NP + C_SX + ch); float xv[8]; unpack8(xw, xv);
                const float* cw = a.in(I_CONVW) + (size_t)(l * 4 + w) * 768 + ch; const f32x4 w0 = *(const f32x4*)cw, w1 = *(const f32x4*)(cw + 4);
#pragma unroll
                for (int i = 0; i < 4; ++i) { acc[i] += xv[i] * w0[i]; acc[4 + i] += xv[4 + i] * w1[i]; } } }
#pragma unroll
        for (int i = 0; i < 8; ++i) acc[i] = siluf_(acc[i]);
        if (c8 < 32) {
            if (PH == 1) { const int e = c8 >> 3; const float wgt = DT[e * 64 + t] * __expf(CH[e * 64 + 63] - CH[e * 64 + t]);
#pragma unroll
                for (int i = 0; i < 8; ++i) acc[i] *= wgt; }
            *(LAS u32x4*)(V + t * LDV + c8 * 8) = pack8(acc);
        } else if (c8 < 40) *(LAS u32x4*)(KT + t * 72 + (c8 - 32) * 8) = pack8(acc);
        else *(LAS u32x4*)(QT + t * 72 + (c8 - 40) * 8) = pack8(acc);
    }
    __syncthreads();
    if (PH == 1) {
        float* loc = (float*)(a.ws() + WS_LOCAL + 3 * LOCAL_BR);
        tile_mm<16, 4, 2>(wave, lane,
            [&](int m0, int ks) { return frag_ks(V, LDV, m0, ks * 32, lane); },
            [&](int n0, int ks) { return frag_ks(KT, 72, n0, ks * 32, lane); },
            [&](int hp, int m0, const f32x4& acc) { const int e = hp >> 6, p = hp & 63; *(f32x4*)(loc + ((size_t)((bl * 8 + g * 4 + e) * 64 + c) * 64 + p) * 64 + m0) = acc; });
        if (tid < 256) ((float*)(a.ws() + WS_DEC + 3 * DEC_BR))[(size_t)((bl * 8 + g * 4 + wave) * 64 + c) * 64 + lane] = __expf(CH[wave * 64 + 63]);
        __syncthreads();
    } else {
        LAS float* GS = (LAS float*)(lds + OFF_CUM);
        tile_mm<4, 4, 2>(wave, lane,
            [&](int m0, int ks) { return frag_kc(QT, 72, m0, ks * 32, lane); },
            [&](int n0, int ks) { return frag_kc(KT, 72, n0, ks * 32, lane); },
            [&](int t, int s0, const f32x4& acc) { *(LAS f32x4*)(GS + t * 68 + s0) = acc; });
        __syncthreads();
        LAS bf16_t* O16 = (LAS bf16_t*)(lds + OFF_O);
        for (int e = 0; e < 4; ++e) {
            const int hh = g * 4 + e;
            { const bf16_t* S = (const bf16_t*)(a.ws() + WS_STATE + 3 * STATE_BR) + (size_t)((bl * 8 + hh) * 64 + c) * 4096; const int p = tid >> 3, m8 = (tid & 7) * 8;
              *(LAS u32x4*)(ST + p * 72 + m8) = *(const u32x4*)(S + p * 64 + m8); }
            { const int t = tid >> 3, s8 = (tid & 7) * 8; const float cht = CH[e * 64 + t];
              const f32x4 g0 = *(const LAS f32x4*)(GS + t * 68 + s8), g1 = *(const LAS f32x4*)(GS + t * 68 + s8 + 4);
              float pv[8];
#pragma unroll
              for (int i = 0; i < 8; ++i) { const int s = s8 + i; const float gv = (i < 4) ? g0[i & 3] : g1[i & 3];
                  pv[i] = (s <= t) ? gv * __expf(cht - CH[e * 64 + s]) * DT[e * 64 + s] : 0.f; }
              *(LAS u32x4*)(AM + t * 136 + s8) = pack8(pv);
              const u32x4 cw = *(const LAS u32x4*)(QT + t * 72 + s8); float cv[8]; unpack8(cw, cv); const float ec = __expf(cht);
#pragma unroll
              for (int i = 0; i < 8; ++i) cv[i] *= ec;
              *(LAS u32x4*)(AM + t * 136 + 64 + s8) = pack8(cv); }
            __syncthreads();
            const float Dh = a.in(I_SSMD)[l * 8 + hh];
            tile_mm<4, 4, 4>(wave, lane,
                [&](int m0, int ks) { return frag_kc(AM, 136, m0, ks * 32, lane); },
                [&](int n0, int ks) { return ks < 2 ? frag_ks(V + e * 64, LDV, n0, ks * 32, lane) : frag_kc(ST, 72, n0, (ks - 2) * 32, lane); },
                [&](int t, int p0, const f32x4& acc) {
                    const u32x2 xw = *(const LAS u32x2*)(V + t * LDV + e * 64 + p0);
                    const u32x2 zw = *(const u32x2*)(P + (size_t)t * NP + C_SZ + g * 256 + e * 64 + p0);
                    const float xv[4] = {bflo(xw.x), bfhi(xw.x), bflo(xw.y), bfhi(xw.y)}, zv[4] = {bflo(zw.x), bfhi(zw.x), bflo(zw.y), bfhi(zw.y)};
                    float y[4];
#pragma unroll
                    for (int j = 0; j < 4; ++j) y[j] = (acc[j] + Dh * xv[j]) * siluf_(zv[j]);
                    u32x2 w; w.x = pk2(y[0], y[1]); w.y = pk2(y[2], y[3]); *(LAS u32x2*)(O16 + t * LDV + e * 64 + p0) = w; });
            __syncthreads();
        }
        const int t = tid >> 3, sub = tid & 7;
        float y[32]; float ss = 0.f;
#pragma unroll
        for (int j = 0; j < 4; ++j) { const u32x4 w = *(const LAS u32x4*)(O16 + t * LDV + sub * 32 + 8 * j); float f[8]; unpack8(w, f);
#pragma unroll
            for (int i = 0; i < 8; ++i) { y[8 * j + i] = f[i]; ss += f[i] * f[i]; } }
        ss += __shfl_xor(ss, 1); ss += __shfl_xor(ss, 2); ss += __shfl_xor(ss, 4);
        const float r = 1.0f / sqrtf(ss * (1.0f / 256.0f) + EPS);
        const float* nw = a.in(I_SNORM) + l * 512 + g * 256 + sub * 32;
        bf16_t* op = P + (size_t)t * NP + C_SZ + g * 256 + sub * 32;
#pragma unroll
        for (int j = 0; j < 4; ++j) { const f32x4 w0 = *(const f32x4*)(nw + 8 * j), w1 = *(const f32x4*)(nw + 8 * j + 4); float res[8];
#pragma unroll
            for (int i = 0; i < 4; ++i) { res[i] = y[8 * j + i] * r * w0[i]; res[4 + i] = y[8 * j + 4 + i] * r * w1[i]; }
            *(u32x4*)(op + 8 * j) = pack8(res); }
        __syncthreads();
    }
}

template <int PH>
__device__ __forceinline__ void phase_mixer(const KA a, LAS unsigned char* lds, int l, int tid) {
    const int G = gridDim.x, bid = blockIdx.x;
    for (int u = bid; u < 512; u += G) unit_mamba<PH>(a, lds, l, u >> 7, (u >> 6) & 1, u & 63, tid);
    for (int u = bid; u < 1024; u += G) unit_gl<0, PH>(a, lds, l, u >> 8, (u >> 6) & 3, u & 63, tid);
    for (int u = bid; u < 1024; u += G) unit_gl<1, PH>(a, lds, l, u >> 8, (u >> 6) & 3, u & 63, tid);
    for (int u = bid; u < 1024; u += G) unit_ret<PH>(a, lds, l, u >> 8, (u >> 6) & 3, u & 63, tid);
}

__device__ __forceinline__ void phase_scan(const KA a, int tid) {
    const int nthr = gridDim.x * 512;
    for (int gt = blockIdx.x * 512 + tid; gt < 4 * 32768; gt += nthr) {
        const int br = gt >> 15, r = gt & 32767;
        const int E = (br == 3) ? 4096 : 8192;
        const int per = E / 4;
        const int bh = r / per, e4 = r % per, k0 = (e4 * 4) & 63;
        const float* loc = (const float*)(a.ws() + WS_LOCAL + br * LOCAL_BR) + (size_t)bh * 64 * E + e4 * 4;
        const float* dec = (const float*)(a.ws() + WS_DEC + br * DEC_BR) + (size_t)bh * 64 * 64 + k0;
        bf16_t* st = (bf16_t*)(a.ws() + WS_STATE + br * STATE_BR) + (size_t)bh * 64 * E + e4 * 4;
        f32x4 S = (f32x4){0.f, 0.f, 0.f, 0.f};
        for (int c0 = 0; c0 < 64; c0 += 8) {
            f32x4 L[8], Dv[8];
#pragma unroll
            for (int i = 0; i < 8; ++i) { L[i] = *(const f32x4*)(loc + (size_t)(c0 + i) * E); Dv[i] = *(const f32x4*)(dec + (c0 + i) * 64); }
#pragma unroll
            for (int i = 0; i < 8; ++i) { u32x2 w; w.x = pk2(S.x, S.y); w.y = pk2(S.z, S.w); *(u32x2*)(st + (size_t)(c0 + i) * E) = w; S = Dv[i] * S + L[i]; }
        }
    }
}

constexpr int NPH_PER = 7, NPHASE = DEPTH * 2 * NPH_PER + 1;
__global__ void __launch_bounds__(512, 2) fwd(Args ka) {
    extern __shared__ __attribute__((aligned(16))) unsigned char lds_raw[];
    LAS unsigned char* lds = (LAS unsigned char*)lds_raw;
    const int tid = threadIdx.x, lane = tid & 63, wave = __builtin_amdgcn_readfirstlane(tid >> 6);
    const int G = gridDim.x;
    const int gw = blockIdx.x * 8 + wave, ngw = G * 8;
    volatile LAS unsigned* MISC = (volatile LAS unsigned*)(lds + MISC_OFF);
    if (tid < 16) MISC[tid] = 0u;
    if (tid < 18) ((volatile LAS unsigned long long*)(lds + MISC_OFF + 64))[tid] = (unsigned long long)ka.in[tid];
    if (tid == 18) ((volatile LAS unsigned long long*)(lds + MISC_OFF + 64))[18] = (unsigned long long)ka.out;
    if (tid == 19) ((volatile LAS unsigned long long*)(lds + MISC_OFF + 64))[19] = (unsigned long long)ka.ws;
    __syncthreads();
    const KA a{lds};
    const int ph_lo = ka.ph_lo, ph_hi = ka.ph_hi, single = ka.single;
    XcdBarrier bar; bar.bar = (unsigned*)(ka.ws + WS_CTL); bar.x = 0; bar.st = MISC + 8;
    if (single) bar = xcd_barrier_post((unsigned*)(ka.ws + WS_CTL), MISC + 8);
#define IN(p) (ph_lo <= (p) && (p) < ph_hi)
#define GRID_BAR() do { if (single) xcd_barrier(bar); } while (0)
#define OPQ_TID() ({ int t__ = threadIdx.x; asm volatile("" : "+v"(t__)); t__; })
    for (int l = 0; l < DEPTH; ++l) {
        for (int hf = 0; hf < 2; ++hf) {
            const int pb = (l * 2 + hf) * NPH_PER;
            const size_t rowoff = (size_t)hf * MH;
            const float* xin = ((l == 0) ? a.in(I_X) : a.out()) + rowoff * D;
            float* xout = a.out() + rowoff * D;
            bf16_t* HB = (bf16_t*)(a.ws() + WS_HB);
            bf16_t* PROJ = (bf16_t*)(a.ws() + WS_PROJ);
            if (EN_N && IN(pb + 0)) {
                const int t_ = OPQ_TID(), lane_ = t_ & 63, wave_ = __builtin_amdgcn_readfirstlane(t_ >> 6), gw_ = blockIdx.x * 8 + wave_;
                if (hf == 0) { phase_weights(a, lds, l, gw_, ngw, wave_, lane_); if (l == 0) phase_rope(a, blockIdx.x * 512 + t_, G * 512); }
                phase_norm(xin, a.in(I_NORMW) + l * D, HB, MH, gw_, ngw, lane_);
                GRID_BAR();
            }
            if (EN_A && IN(pb + 1)) {
                pg8::Gemm g{HB, (const bf16_t*)(a.ws() + WS_WIN), MH, NP, D, D, D}; pg8::StaticOrder S; S.init(MH, NP, G, (int)blockIdx.x);
                pg8::EpiProj E{PROJ};
                pg8::gemm_phase<pg8::EpiProj, true>(lds, g, S, E, OPQ_TID());
                GRID_BAR();
            }
            if (EN_B1 && IN(pb + 2)) { phase_mixer<1>(a, lds, l, OPQ_TID()); GRID_BAR(); }
            if (EN_B2 && IN(pb + 3)) { phase_scan(a, OPQ_TID()); GRID_BAR(); }
            if (EN_B3 && IN(pb + 4)) { phase_mixer<3>(a, lds, l, OPQ_TID()); GRID_BAR(); }
            if (EN_C && IN(pb + 5)) {
                for (int n = 0; n < 4; ++n) {
                    const int coln = (n == 0) ? C_GG : (n == 1) ? C_HG : (n == 2) ? C_SZ : C_RG;
                    pg8::Gemm g{PROJ + coln, (const bf16_t*)(a.ws() + WS_WUP) + (size_t)n * 1024 * 512, MH, D, 512, NP, 512}; pg8::StaticOrder S; S.init(MH, D, G, (int)blockIdx.x);
                    pg8::EpiUp E{PROJ + C_MG + n * 1024, HB, n == 0 ? 1 : 0};
                    pg8::gemm_phase<pg8::EpiUp, false>(lds, g, S, E, OPQ_TID());
                }
                GRID_BAR();
            }
            if (EN_D && IN(pb + 6)) {
                pg8::Gemm g{HB, (const bf16_t*)(a.ws() + WS_WOUT), MH, D, D, D, D}; pg8::StaticOrder S; S.init(MH, D, G, (int)blockIdx.x);
                pg8::EpiOut E{xin, xout};
                pg8::gemm_phase<pg8::EpiOut, false>(lds, g, S, E, OPQ_TID());
                GRID_BAR();
            }
        }
    }
    if (IN(NPHASE - 1)) phase_final(a.out(), a.in(I_FNORM), BATCH * SEQ, gw, ngw, lane);
#undef IN
#undef GRID_BAR
}

extern "C" void kernel_launch(void* const* d_in, const int* in_sizes, int n_in, void* d_out, int out_size, void* d_ws, size_t ws_size, hipStream_t stream) {
    static int grid = 0;
    if (grid == 0) {
        if (n_in != 18 || in_sizes[0] != BATCH * SEQ * D || out_size != BATCH * SEQ * D || ws_size < WS_END) {
            fprintf(stderr, "kernel_launch: unexpected shapes (n_in %d, in0 %d, out %d, ws %zu, need %zu)\n", n_in, n_in > 0 ? in_sizes[0] : -1, out_size, ws_size, (size_t)WS_END); grid = -1; return; }
        int dev = 0, cus = 0, per_cu = 0;
        if (hipGetDevice(&dev) != hipSuccess || hipDeviceGetAttribute(&cus, hipDeviceAttributeMultiprocessorCount, dev) != hipSuccess) { grid = -1; return; }
        if (hipFuncSetAttribute((const void*)fwd, hipFuncAttributeMaxDynamicSharedMemorySize, LDS_BYTES) != hipSuccess) { fprintf(stderr, "kernel_launch: hipFuncSetAttribute failed\n"); grid = -1; return; }
        if (hipOccupancyMaxActiveBlocksPerMultiprocessor(&per_cu, (const void*)fwd, 512, LDS_BYTES) != hipSuccess || per_cu < 1)
            fprintf(stderr, "kernel_launch: occupancy query reports %d workgroups per CU\n", per_cu);
        (void)hipGetLastError();
        grid = cus;
    }
    if (grid < 0) return;
    (void)hipMemsetAsync((char*)d_ws + WS_CTL, 0, CTL_BYTES, stream);
    Args a{};
    for (int i = 0; i < 18; ++i) a.in[i] = (const float*)d_in[i];
    a.out = (float*)d_out; a.ws = (unsigned char*)d_ws; a.pad = 0;
#if MK_PER_PHASE_LAUNCH
    for (int p = 0; p < NPHASE; ++p) { a.ph_lo = p; a.ph_hi = p + 1; a.single = 0; hipLaunchKernelGGL(fwd, dim3(grid), dim3(512), LDS_BYTES, stream, a); }
#else
    a.ph_lo = 0; a.ph_hi = NPHASE; a.single = 1;
    hipLaunchKernelGGL(fwd, dim3(grid), dim3(512), LDS_BYTES, stream, a);
#endif
}
```

```cpp
#include <hip/hip_runtime.h>
#ifndef EN_N
#define EN_N 1
#define EN_A 1
#define EN_B1 1
#define EN_B2 1
#define EN_B3 1
#define EN_C 1
#define EN_D 1
#endif
#include <cstdio>
#include <cstdint>

#ifndef DUP_PHASE
#define DUP_PHASE -1
#endif
#ifndef MK_PER_PHASE_LAUNCH
#define MK_PER_PHASE_LAUNCH 0
#endif

#define LAS __attribute__((address_space(3)))
typedef unsigned short bf16_t;
typedef short bf16x8 __attribute__((ext_vector_type(8)));
typedef float f32x4 __attribute__((ext_vector_type(4)));
typedef unsigned u32x4 __attribute__((ext_vector_type(4)));
typedef unsigned u32x2 __attribute__((ext_vector_type(2)));

constexpr int D = 1024, BATCH = 8, SEQ = 4096, DEPTH = 4, NIN = 10008, NP = 10240, PLD = 6144;
constexpr int HBATCH = 4, MH = HBATCH * SEQ;
constexpr float EPS = 1e-6f;
constexpr int C_GQ = 0, C_GK = 256, C_GV = 512, C_GG = 1024, C_HQ = 1536, C_HF = 1792, C_HI = 2048, C_HG = 2560, C_SZ = 3072, C_SX = 3584,
              C_RQ = 4352, C_RK = 4608, C_RV = 4864, C_RG = 5376, C_LR = 5888, C_DT = 5904, C_MG = 6144;
__host__ __device__ __forceinline__ int origcol(int c) {
    if (c < 1024) return c;
    if (c < 4352) return c + 16;
    if (c < 5888) return c + 24;
    if (c < 5904) return c - 5888 + 1024;
    if (c < 5912) return c - 5904 + 4368;
    if (c < 6144) return -1;
    return c - 232;
}
enum { I_X = 0, I_NORMW, I_WIN, I_WLR, I_BLR, I_GNORM, I_HLB, I_HNORM, I_CONVW, I_CONVB, I_DTB, I_ALOG, I_SSMD, I_SNORM, I_RNORM, I_WUP, I_WOUT, I_FNORM };

constexpr size_t WS_CTL = 0, CTL_BYTES = 16384;
constexpr size_t WS_ROPE = 65536;
constexpr size_t WS_WIN = WS_ROPE + 2 * 4096 * 32 * 4;
constexpr size_t WS_WUP = WS_WIN + (size_t)NP * 1024 * 2;
constexpr size_t WS_WOUT = WS_WUP + (size_t)4 * 1024 * 512 * 2;
constexpr size_t WS_HB = WS_WOUT + (size_t)1024 * 1024 * 2;
constexpr size_t WS_PROJ = WS_HB + (size_t)MH * 1024 * 2;
constexpr size_t LOCAL_BR = (size_t)16 * 64 * 128 * 64 * 4;
constexpr size_t WS_GATES = WS_PROJ + (size_t)MH * PLD * 2;
constexpr size_t WS_LOCAL = WS_GATES + (size_t)MH * 4096 * 2;
constexpr size_t STATE_BR = LOCAL_BR / 2;
constexpr size_t WS_STATE = WS_LOCAL + 4 * LOCAL_BR;
constexpr size_t DEC_BR = (size_t)32 * 64 * 64 * 4;
constexpr size_t WS_DEC = WS_STATE + 4 * STATE_BR;
constexpr size_t WS_END = WS_DEC + 4 * DEC_BR;
constexpr size_t WS_OUTN = WS_LOCAL;
constexpr size_t OUTN_BR = (size_t)MH * 512 * 2;

constexpr int LDS_BYTES = 147456;
constexpr int MISC_OFF = LDS_BYTES - 256;
constexpr int OFF_CUM = 0, OFF_SEG = 17408, OFF_QT = 19456, OFF_KT = 28672, OFF_AM = 37888, OFF_V = 55296, OFF_ST = 89088, OFF_O = 107520;
constexpr int LDV = 264;
constexpr int OFF_OML = 141312;

namespace pg8 {
constexpr int BM = 256, BK = 64, HALF = 128, HTB = HALF * BK * 2, STAGE_BYTES = 8 * HTB, NXCD = 8, WGM = 8;
__host__ __device__ __forceinline__ int lds_byte(int r, int c) { const int st = (r >> 4) * 2 + (c >> 5), rr = r & 15, cc = c & 31, ob = rr * 64 + cc * 2; return st * 1024 + (ob ^ (((ob >> 9) & 1) << 5)); }
__host__ __device__ __forceinline__ void stage_rc(int b, int& R, int& C) { const int st = b / 1024, sb = b % 1024, swz = sb ^ (((sb >> 9) & 1) << 5); R = (st >> 1) * 16 + swz / 64; C = (st & 1) * 32 + (swz % 64) / 2; }
__host__ __device__ __forceinline__ int perm32(int rho) { const int n = rho >> 4, i = rho & 15; return 8 * (i >> 2) + 4 * n + (i & 3); }
struct Unit { int pm, pn; };
struct Gemm { const bf16_t* A; const bf16_t* Bt; int M, N, K, lda, ldb; int kseg; size_t segA, segB; };
struct StaticOrder {
    int nM, nN, nwg, G, c;
    __host__ __device__ void init(int M, int N, int G_, int c_) { nM = M / BM; nN = N / BM; nwg = nM * nN; G = G_; c = c_; }
    __host__ __device__ bool next(int i, Unit& u) const {
        const long L = (long)i * G + c; if (L >= nwg) return false;
        int wgid = (int)L; { const int q = nwg / NXCD, r = nwg % NXCD, xcd = wgid % NXCD, off = wgid / NXCD; wgid = (xcd < r ? xcd * (q + 1) : r * (q + 1) + (xcd - r) * q) + off; }
        const int nig = WGM * nN, gid = wgid / nig, fm = gid * WGM, gsz = (nM - fm) < WGM ? (nM - fm) : WGM;
        u.pm = fm + ((wgid % nig) % gsz); u.pn = (wgid % nig) / gsz; return true;
    }
};
__device__ __forceinline__ unsigned cvt_pk_bf16(float lo, float hi) { unsigned r; asm volatile("v_cvt_pk_bf16_f32 %0, %1, %2" : "=v"(r) : "v"(lo), "v"(hi)); return r; }

struct EpiProj {
    static constexpr bool PERM = true, SEG = false;
    bf16_t* O; unsigned char* Gt;
    __device__ __forceinline__ void operator()(const f32x4 (&acc)[2][2][4][2], const Unit& u, int wr, int wc, int fr, int fq) const {
        const int row0 = u.pm * BM + wr * 64 + fr, col0 = u.pn * BM + wc * 32 + 8 * fq;
        const bool sig = u.pn >= 24;
        unsigned char* gt = Gt + ((size_t)(u.pm * 16 + (u.pn - 24)) * 65536) + ((wr * 4 + wc) * 64 + fq * 16 + fr) * 8;
#pragma unroll
        for (int ai = 0; ai < 2; ++ai)
#pragma unroll
            for (int m = 0; m < 4; ++m) { bf16_t* rowp = O + (size_t)(row0 + ai * HALF + m * 16) * PLD + col0;
#pragma unroll
                for (int bj = 0; bj < 2; ++bj) { f32x4 v0 = acc[ai][bj][m][0], v1 = acc[ai][bj][m][1];
                    if (sig) {
#pragma unroll
                        for (int j = 0; j < 4; ++j) { v0[j] = __builtin_amdgcn_rcpf(1.0f + __expf(-v0[j])); v1[j] = __builtin_amdgcn_rcpf(1.0f + __expf(-v1[j])); } }
                    if (sig) { unsigned qv[8];
#pragma unroll
                        for (int j = 0; j < 4; ++j) { qv[j] = (unsigned)fminf(fmaxf(v0[j] * 255.0f + 0.5f, 1.0f), 255.0f); qv[4 + j] = (unsigned)fminf(fmaxf(v1[j] * 255.0f + 0.5f, 1.0f), 255.0f); }
                        u32x2 w8; w8.x = qv[0] | (qv[1] << 8) | (qv[2] << 16) | (qv[3] << 24); w8.y = qv[4] | (qv[5] << 8) | (qv[6] << 16) | (qv[7] << 24);
                        *(u32x2*)(gt + (size_t)(((ai * 4 + m) * 2 + bj) * 4096)) = w8; }
                    else { u32x4 w; w.x = cvt_pk_bf16(v0[0], v0[1]); w.y = cvt_pk_bf16(v0[2], v0[3]); w.z = cvt_pk_bf16(v1[0], v1[1]); w.w = cvt_pk_bf16(v1[2], v1[3]);
                        *(u32x4*)(rowp + bj * HALF) = w; } } }
    }
};
struct EpiUp {
    static constexpr bool PERM = true, SEG = true; static constexpr int KSEG = 8;
    const unsigned char* Gt; bf16_t* Mg;
    __device__ __forceinline__ void mid(f32x4 (&acc)[2][2][4][2], const Unit& u, int seg, int wr, int wc, int fr, int fq) const {
        const unsigned char* gpv = Gt + ((size_t)(u.pm * 16 + (seg - 1) * 4 + u.pn) * 65536) + ((wr * 4 + wc) * 64 + fq * 16 + fr) * 8;
#pragma unroll
        for (int ai = 0; ai < 2; ++ai)
#pragma unroll
            for (int mp = 0; mp < 2; ++mp) {
                u32x2 gp[2][2], gc[2][2];
#pragma unroll
                for (int mm = 0; mm < 2; ++mm)
#pragma unroll
                    for (int bj = 0; bj < 2; ++bj) { const unsigned char* q = gpv + (size_t)(((ai * 4 + mp * 2 + mm) * 2 + bj) * 4096); gp[mm][bj] = *(const u32x2*)q; gc[mm][bj] = *(const u32x2*)(q + 4 * 65536); }
#pragma unroll
                for (int mm = 0; mm < 2; ++mm)
#pragma unroll
                    for (int bj = 0; bj < 2; ++bj) { const int m = mp * 2 + mm;
#pragma unroll
                        for (int e = 0; e < 8; ++e) {
                            const float pv = (float)((gp[mm][bj][e >> 2] >> (8 * (e & 3))) & 0xffu), cv = (float)((gc[mm][bj][e >> 2] >> (8 * (e & 3))) & 0xffu);
                            acc[ai][bj][m][e >> 2][e & 3] *= pv * __builtin_amdgcn_rcpf(cv); } }
                asm volatile("" ::: "memory");
            }
    }
    __device__ __forceinline__ void operator()(const f32x4 (&acc)[2][2][4][2], const Unit& u, int wr, int wc, int fr, int fq) const {
        const int row0 = u.pm * BM + wr * 64 + fr, col0 = u.pn * BM + wc * 32 + 8 * fq;
        const unsigned char* gpv = Gt + ((size_t)(u.pm * 16 + 3 * 4 + u.pn) * 65536) + ((wr * 4 + wc) * 64 + fq * 16 + fr) * 8;
#pragma unroll
        for (int ai = 0; ai < 2; ++ai)
#pragma unroll
            for (int m = 0; m < 4; ++m) { const size_t r = (size_t)(row0 + ai * HALF + m * 16);
#pragma unroll
                for (int bj = 0; bj < 2; ++bj) { const int c = col0 + bj * HALF;
                    const u32x2 g = *(const u32x2*)(gpv + (size_t)(((ai * 4 + m) * 2 + bj) * 4096));
                    float res[8];
#pragma unroll
                    for (int e = 0; e < 8; ++e) res[e] = acc[ai][bj][m][e >> 2][e & 3] * ((float)((g[e >> 2] >> (8 * (e & 3))) & 0xffu) * (1.0f / 255.0f));
                    u32x4 w; w.x = cvt_pk_bf16(res[0], res[1]); w.y = cvt_pk_bf16(res[2], res[3]); w.z = cvt_pk_bf16(res[4], res[5]); w.w = cvt_pk_bf16(res[6], res[7]);
                    *(u32x4*)(Mg + r * 1024 + c) = w; } }
    }
};
struct EpiOut {
    static constexpr bool PERM = false, SEG = false;
    const float* Xin; float* Xout;
    __device__ __forceinline__ void operator()(const f32x4 (&acc)[2][2][4][2], const Unit& u, int wr, int wc, int fr, int fq) const {
        const int row0 = u.pm * BM + wr * 64 + fr, col0 = u.pn * BM + wc * 32 + 4 * fq;
#pragma unroll
        for (int ai = 0; ai < 2; ++ai)
#pragma unroll
            for (int m = 0; m < 4; ++m) { const size_t ro = (size_t)(row0 + ai * HALF + m * 16) * 1024 + col0;
#pragma unroll
                for (int bj = 0; bj < 2; ++bj)
#pragma unroll
                    for (int n = 0; n < 2; ++n) { const size_t o = ro + bj * HALF + n * 16; *(f32x4*)(Xout + o) = *(const f32x4*)(Xin + o) + acc[ai][bj][m][n]; } }
    }
};

template <class Epi, bool ALIGN_EPI>
__device__ __forceinline__ void gemm_phase(LAS unsigned char* lds, const Gemm g, const StaticOrder& S, const Epi& E, const int tid) {
    const int wid = __builtin_amdgcn_readfirstlane(tid >> 6), lane = tid & 63, wr = wid >> 2, wc = wid & 3, fr = lane & 15, fq = lane >> 4;
    const int K = g.K, nt = K / BK;
    unsigned voffA[2], voffB[2];
#pragma unroll
    for (int i = 0; i < 2; ++i) { int R, C; stage_rc(tid * 16 + i * 8192, R, C); const int Rb = Epi::PERM ? ((R & ~31) + perm32(R & 31)) : R;
        voffA[i] = (unsigned)(R * g.lda + C) * 2u; voffB[i] = (unsigned)(Rb * g.ldb + C) * 2u; }
    const size_t kstep = (size_t)(BK * 2);
    const size_t hstepA = (size_t)HALF * g.lda * 2, hstepB = (size_t)HALF * g.ldb * 2;
    const size_t tstepA = 2 * hstepA, tstepB = 2 * hstepB;
    const unsigned ldsw = (unsigned)wid * 1024u;
    const int aoff = lds_byte(wr * 64 + fr, fq * 8), boff = lds_byte(wc * 32 + fr, fq * 8);
#define PG8_SA(b, h) (((b) * 2 + (h)) * HTB)
#define PG8_SB(b, h) ((4 + (b) * 2 + (h)) * HTB)
#define PG8_STAGE(bufoff, gbase, voff) do { _Pragma("unroll") for (int _i = 0; _i < 2; ++_i) \
        __builtin_amdgcn_global_load_lds((const unsigned*)((const char*)(gbase) + (voff)[_i]), (LAS unsigned*)(lds + (bufoff) + ldsw + _i * 8192), 16, 0, 0); } while (0)
#define PG8_LDA(dst, b, h) do { _Pragma("unroll") for (int m = 0; m < 4; ++m) _Pragma("unroll") for (int k = 0; k < 2; ++k) dst[m][k] = *(const LAS bf16x8*)(lds + PG8_SA(b, h) + aoff + m * 2048 + k * 1024); } while (0)
#define PG8_LDB(dst, b, h) do { _Pragma("unroll") for (int n = 0; n < 2; ++n) _Pragma("unroll") for (int k = 0; k < 2; ++k) dst[n][k] = *(const LAS bf16x8*)(lds + PG8_SB(b, h) + boff + n * 2048 + k * 1024); } while (0)
#define PG8_MMA(ai, bj, At, Bt) do { __builtin_amdgcn_s_setprio(1); _Pragma("unroll") for (int m = 0; m < 4; ++m) _Pragma("unroll") for (int n = 0; n < 2; ++n) _Pragma("unroll") for (int k = 0; k < 2; ++k) \
        acc[ai][bj][m][n] = __builtin_amdgcn_mfma_f32_16x16x32_bf16(Bt[n][k], At[m][k], acc[ai][bj][m][n], 0, 0, 0); __builtin_amdgcn_s_setprio(0); } while (0)
#define PG8_WAIT_V(n) asm volatile("s_waitcnt vmcnt(" #n ")" ::: "memory")
#define PG8_WAIT_L(n) asm volatile("s_waitcnt lgkmcnt(" #n ")" ::: "memory")
#define PG8_BAR __builtin_amdgcn_s_barrier()
#define PG8_SCHED __builtin_amdgcn_sched_barrier(0)
    Unit cur, nxt; int ui = 0;
    if (!S.next(0, cur)) return;
    f32x4 acc[2][2][4][2];
#pragma unroll
    for (int a = 0; a < 2; ++a)
#pragma unroll
        for (int b = 0; b < 2; ++b)
#pragma unroll
            for (int m = 0; m < 4; ++m)
#pragma unroll
                for (int n = 0; n < 2; ++n) acc[a][b][m][n] = (f32x4){0.f, 0.f, 0.f, 0.f};
    bf16x8 At[4][2], B0[2][2], B1[2][2];
    const char* cA = (const char*)g.A + (size_t)cur.pm * tstepA; const char* cB = (const char*)g.Bt + (size_t)cur.pn * tstepB;
    PG8_STAGE(PG8_SB(0, 0), cB, voffB); PG8_STAGE(PG8_SB(0, 1), cB + hstepB, voffB); PG8_STAGE(PG8_SA(0, 0), cA, voffA); PG8_STAGE(PG8_SA(0, 1), cA + hstepA, voffA);
    if (wr == 1) PG8_BAR;
    PG8_WAIT_V(2); PG8_BAR;
    PG8_STAGE(PG8_SB(1, 0), cB + kstep, voffB); PG8_STAGE(PG8_SA(1, 0), cA + kstep, voffA); PG8_STAGE(PG8_SB(1, 1), cB + hstepB + kstep, voffB);
    PG8_WAIT_V(6); PG8_BAR;
    for (;;) {
        const bool has_next = S.next(ui + 1, nxt);
        const char* nA = has_next ? (const char*)g.A + (size_t)nxt.pm * tstepA : cA; const char* nB = has_next ? (const char*)g.Bt + (size_t)nxt.pn * tstepB : cB;
        for (int t = 0; t < nt; t += 2) {
            const bool last = (t == nt - 2);
            size_t oA1, oA2, oB2;
            if constexpr (Epi::SEG) { constexpr int KS = Epi::KSEG; const int s0 = t / KS, t0 = t % KS, s2 = (t + 2) / KS, t2 = (t + 2) % KS;
                oA1 = (size_t)s0 * g.segA + (size_t)(t0 + 1) * kstep; oA2 = (size_t)s2 * g.segA + (size_t)t2 * kstep; oB2 = (size_t)s2 * g.segB + (size_t)t2 * kstep;
                if (t0 == 0 && t > 0) { if (wr == 0) PG8_BAR; E.mid(acc, cur, s0, wr, wc, fr, fq); if (wr == 1) PG8_BAR; } }
            else { oA1 = (size_t)(t + 1) * kstep; oA2 = (size_t)(t + 2) * kstep; oB2 = oA2; }
            const char* a1 = cA + oA1;
            const char* a2 = last ? nA : cA + oA2; const char* b2 = last ? nB : cB + oB2;
            const char* a3 = a2 + kstep; const char* b3 = b2 + kstep;
            PG8_LDB(B0, 0, 0); PG8_LDB(B1, 0, 1); PG8_SCHED; PG8_LDA(At, 0, 0); PG8_STAGE(PG8_SA(1, 1), a1 + hstepA, voffA);
            PG8_WAIT_V(8); PG8_WAIT_L(0); PG8_BAR; PG8_MMA(0, 0, At, B0); PG8_MMA(0, 1, At, B1); PG8_BAR; PG8_SCHED;
            PG8_LDA(At, 0, 1); PG8_STAGE(PG8_SB(0, 0), b2, voffB); PG8_STAGE(PG8_SB(0, 1), b2 + hstepB, voffB); PG8_STAGE(PG8_SA(0, 0), a2, voffA);
            PG8_WAIT_V(8); PG8_WAIT_L(0); PG8_BAR; PG8_MMA(1, 0, At, B0); PG8_MMA(1, 1, At, B1); PG8_BAR; PG8_SCHED;
            PG8_LDB(B0, 1, 0); PG8_LDB(B1, 1, 1); PG8_SCHED; PG8_LDA(At, 1, 0); PG8_STAGE(PG8_SA(0, 1), a2 + hstepA, voffA);
            PG8_WAIT_V(8); PG8_WAIT_L(0); PG8_BAR; PG8_MMA(0, 0, At, B0); PG8_MMA(0, 1, At, B1); PG8_BAR; PG8_SCHED;
            PG8_LDA(At, 1, 1); PG8_STAGE(PG8_SB(1, 0), b3, voffB); PG8_STAGE(PG8_SB(1, 1), b3 + hstepB, voffB); PG8_STAGE(PG8_SA(1, 0), a3, voffA);
            PG8_WAIT_V(8); PG8_WAIT_L(0); PG8_BAR; PG8_MMA(1, 0, At, B0); PG8_MMA(1, 1, At, B1); PG8_BAR; PG8_SCHED;
        }
        if constexpr (ALIGN_EPI) { if (wr == 0) PG8_BAR; }
        E(acc, cur, wr, wc, fr, fq);
        if (!has_next) break;
#pragma unroll
        for (int a = 0; a < 2; ++a)
#pragma unroll
            for (int b = 0; b < 2; ++b)
#pragma unroll
                for (int m = 0; m < 4; ++m)
#pragma unroll
                    for (int n = 0; n < 2; ++n) acc[a][b][m][n] = (f32x4){0.f, 0.f, 0.f, 0.f};
        cur = nxt; cA = nA; cB = nB; ++ui;
        if constexpr (ALIGN_EPI) { if (wr == 1) PG8_BAR; }
    }
    PG8_WAIT_V(0);
    if constexpr (!ALIGN_EPI) { if (wr == 0) PG8_BAR; }
    PG8_BAR;
#undef PG8_SA
#undef PG8_SB
#undef PG8_STAGE
#undef PG8_LDA
#undef PG8_LDB
#undef PG8_MMA
#undef PG8_WAIT_V
#undef PG8_WAIT_L
#undef PG8_BAR
#undef PG8_SCHED
}
}

#define XB_TMO      128
#define XB_XCNT(j)  (256  + 64 * (j))
#define XB_XSUB(j)  (1280 + 64 * (j))
#define XB_XGEN(j)  (2304 + 64 * (j))
#define XB_TOP      3328
#define XB_TOPGEN   3392
#define XCD_BAR_WORDS 3456
#define XB_SPIN_CAP (1u << 18)
__device__ __forceinline__ unsigned xb_ld(unsigned* p)              { return __hip_atomic_load(p, __ATOMIC_RELAXED, __HIP_MEMORY_SCOPE_AGENT); }
__device__ __forceinline__ unsigned xb_add(unsigned* p, unsigned v) { return __hip_atomic_fetch_add(p, v, __ATOMIC_RELAXED, __HIP_MEMORY_SCOPE_AGENT); }
__device__ __forceinline__ unsigned xb_xcc_id() { return (unsigned)__builtin_amdgcn_s_getreg((3 << 11) | 20) & 0xFu; }
#define XB_SPIN(cond, bar) do { unsigned _sp = 0; while (cond) { __builtin_amdgcn_s_sleep(1); \
    if ((++_sp & 255u) == 0u) { if (xb_ld(&(bar)[XB_TMO])) break; if (_sp > XB_SPIN_CAP) { atomicAdd(&(bar)[XB_TMO], 1u); break; } } } } while (0)
struct XcdBarrier { unsigned* bar; unsigned x; volatile LAS unsigned* st; };
__device__ __forceinline__ XcdBarrier xcd_barrier_post(unsigned* bar, volatile LAS unsigned* st) {
    XcdBarrier b; b.bar = bar; b.x = xb_xcc_id(); b.st = st;
    if (threadIdx.x == 0) (void)xb_add(&bar[XB_XCNT(b.x)], 1u);
    return b;
}
__device__ __forceinline__ void xcd_barrier_complete(unsigned* bar, unsigned x, unsigned& nloc, unsigned& nx) {
    const unsigned G = gridDim.x * gridDim.y * gridDim.z;
    unsigned sum, cnt, mine, sp = 0u;
    for (;;) {
        sum = 0u; cnt = 0u;
        for (unsigned j = 0; j < 16; ++j) { const unsigned c = xb_ld(&bar[XB_XCNT(j)]); sum += c; cnt += (c > 0u) ? 1u : 0u; }
        mine = xb_ld(&bar[XB_XCNT(x)]);
        if (sum == G) break;
        __builtin_amdgcn_s_sleep(1);
        if ((++sp & 255u) == 0u) { if (xb_ld(&bar[XB_TMO])) break; if (sp > XB_SPIN_CAP) { atomicAdd(&bar[XB_TMO], 1u); break; } }
    }
    nloc = mine > 0u ? mine : 1u; nx = cnt > 0u ? cnt : 1u;
}
__device__ __forceinline__ void xcd_barrier(const XcdBarrier& b) {
    asm volatile("s_waitcnt vmcnt(0)" ::: "memory");
    __syncthreads();
    if (threadIdx.x == 0) {
        unsigned* bar = b.bar; asm volatile("" : "+s"(bar));
        __builtin_amdgcn_s_waitcnt(0);
        unsigned nloc = b.st[0], nx = b.st[1];
        if (nloc == 0u) { xcd_barrier_complete(bar, b.x, nloc, nx); b.st[0] = nloc; b.st[1] = nx; }
        const unsigned old = xb_add(&bar[XB_XSUB(b.x)], 1u);
        const unsigned gen = old / nloc;
        if (old + 1u == (gen + 1u) * nloc) {
            __builtin_amdgcn_fence(__ATOMIC_RELEASE, "agent");
            asm volatile("s_waitcnt vmcnt(0)" ::: "memory");
            const unsigned og = xb_add(&bar[XB_TOP], 1u);
            const unsigned tg = og / nx;
            if (og + 1u == (tg + 1u) * nx) xb_add(&bar[XB_TOPGEN], 1u);
            else XB_SPIN(xb_ld(&bar[XB_TOPGEN]) == tg, bar);
            __builtin_amdgcn_fence(__ATOMIC_ACQUIRE, "agent");
            xb_add(&bar[XB_XGEN(b.x)], 1u);
            asm volatile("s_waitcnt vmcnt(0)" ::: "memory");
        } else {
            XB_SPIN(xb_ld(&bar[XB_XGEN(b.x)]) == gen, bar);
            __builtin_amdgcn_fence(__ATOMIC_ACQUIRE, "agent");
            asm volatile("s_waitcnt vmcnt(0)" ::: "memory");
        }
    }
    __syncthreads();
}

#define LDS_WAIT() asm volatile("s_waitcnt lgkmcnt(0)" ::: "memory")
__device__ __forceinline__ float bf2f(unsigned short h) { return __builtin_bit_cast(float, (unsigned)h << 16); }
__device__ __forceinline__ float bflo(unsigned w) { return __builtin_bit_cast(float, w << 16); }
__device__ __forceinline__ float bfhi(unsigned w) { return __builtin_bit_cast(float, w & 0xffff0000u); }
__device__ __forceinline__ unsigned pk2(float lo, float hi) { return pg8::cvt_pk_bf16(lo, hi); }
__device__ __forceinline__ void unpack8(const u32x4 w, float (&f)[8]) {
#pragma unroll
    for (int q = 0; q < 4; ++q) { f[2 * q] = bflo(w[q]); f[2 * q + 1] = bfhi(w[q]); }
}
__device__ __forceinline__ u32x4 pack8(const float (&f)[8]) { u32x4 w; w.x = pk2(f[0], f[1]); w.y = pk2(f[2], f[3]); w.z = pk2(f[4], f[5]); w.w = pk2(f[6], f[7]); return w; }
__device__ __forceinline__ float wave_sum(float v) {
#pragma unroll
    for (int o = 1; o < 64; o <<= 1) v += __shfl_xor(v, o);
    return v;
}
__device__ __forceinline__ float logsig(float x) { return fminf(x, 0.f) - log1pf(expf(-fabsf(x))); }
__device__ __forceinline__ float softplusf_(float x) { return fmaxf(x, 0.f) + log1pf(expf(-fabsf(x))); }
__device__ __forceinline__ float siluf_(float x) { return x / (1.0f + __expf(-x)); }
__device__ __forceinline__ float clampf_(float x, float lo, float hi) { return fminf(fmaxf(x, lo), hi); }

__device__ const double ROPE_INV_TURNS[32] = {
    1.59154943091895346e-01, 1.19349369005342654e-01, 8.94994027620097804e-02, 6.71150846704077902e-02, 5.03292117661844479e-02, 3.77415881547067678e-02, 2.83021955739452893e-02, 2.12236531366118003e-02,
    1.59154945463488816e-02, 1.19349361890562274e-02, 8.94993956472293906e-03, 6.71150811130175919e-03, 5.03292153235746463e-03, 3.77415828186214788e-03, 2.83021961668436560e-03, 2.12236537295101661e-03,
    1.59154939534505145e-03, 1.19349373748529582e-03, 8.94994015762130509e-04, 6.71150796307716838e-04, 5.03292153235746485e-04, 3.77415865242362598e-04, 2.83021961668436560e-04, 2.12236529883872083e-04,
    1.59154950651349498e-04, 1.19349366337300012e-04, 8.94993978705982618e-05, 6.71150898212123409e-05, 5.03292153235746431e-05, 3.77415869874381108e-05, 2.83021957036418071e-05, 2.12236539147909035e-05};

struct Args { const float* in[18]; float* out; unsigned char* ws; int ph_lo, ph_hi, single, pad; };
struct KA {
    LAS unsigned char* lds;
    __device__ __forceinline__ unsigned long long ld(int i) const { volatile LAS unsigned* p = (volatile LAS unsigned*)(lds + MISC_OFF + 64) + 2 * i;
        const unsigned lo = __builtin_amdgcn_readfirstlane(p[0]), hi = __builtin_amdgcn_readfirstlane(p[1]); return ((unsigned long long)hi << 32) | lo; }
    __device__ __forceinline__ const float* in(int i) const { return (const float*)ld(i); }
    __device__ __forceinline__ float* out() const { return (float*)ld(18); }
    __device__ __forceinline__ unsigned char* ws() const { return (unsigned char*)ld(19); }
};

__device__ __forceinline__ bf16x8 frag_kc(const LAS bf16_t* X, int ld, int idx0, int k0, int lane) {
    return *(const LAS bf16x8*)(X + (idx0 + (lane & 15)) * ld + k0 + 8 * (lane >> 4));
}
__device__ __forceinline__ bf16x8 frag_ks(const LAS bf16_t* X, int ld, int idx0, int k0, int lane) {
    const LAS bf16_t* p = X + (k0 + 8 * (lane >> 4)) * ld + idx0 + (lane & 15);
    bf16x8 r;
#pragma unroll
    for (int i = 0; i < 8; ++i) r[i] = (short)p[i * ld];
    return r;
}
template <int MT, int NT, int KS, class FA, class FB, class EP>
__device__ __forceinline__ void tile_mm(int wave, int lane, FA&& fa, FB&& fb, EP&& epi) {
    for (int tix = wave; tix < MT * NT; tix += 8) {
        const int mt = tix % MT, nt = tix / MT;
        f32x4 acc = (f32x4){0.f, 0.f, 0.f, 0.f};
#pragma unroll
        for (int ks = 0; ks < KS; ++ks) { const bf16x8 av = fa(mt * 16, ks), bv = fb(nt * 16, ks); acc = __builtin_amdgcn_mfma_f32_16x16x32_bf16(bv, av, acc, 0, 0, 0); }
        epi(mt * 16 + (lane & 15), nt * 16 + 4 * (lane >> 4), acc);
    }
}

template <bool MAP>
__device__ __forceinline__ void transpose_item(const float* W, int K, int ldw, bf16_t* WT, LAS float* scr, int kb, int nb, int lane) {
    const int k0 = 64 * kb, n0 = 32 * nb;
    int nsrc = n0 + (lane & 31); if (MAP) nsrc = origcol(nsrc);
#pragma unroll 8
    for (int i = 0; i < 32; ++i) { const int kk = 2 * i + (lane >> 5); scr[kk * 33 + (lane & 31)] = (nsrc >= 0) ? W[(size_t)(k0 + kk) * ldw + nsrc] : 0.f; }
    LDS_WAIT(); asm volatile("" ::: "memory");
    const int c = lane & 7;
#pragma unroll
    for (int j = 0; j < 4; ++j) { const int n = (lane >> 3) + 8 * j; const LAS float* s = scr + (8 * c) * 33 + n;
        u32x4 o; o.x = pk2(s[0 * 33], s[1 * 33]); o.y = pk2(s[2 * 33], s[3 * 33]); o.z = pk2(s[4 * 33], s[5 * 33]); o.w = pk2(s[6 * 33], s[7 * 33]);
        *(u32x4*)(WT + (size_t)(n0 + n) * K + k0 + 8 * c) = o; }
    LDS_WAIT(); asm volatile("" ::: "memory");
}
__device__ __forceinline__ void phase_weights(const KA a, LAS unsigned char* lds, int l, int gw, int ngw, int wave, int lane) {
    LAS float* scr = (LAS float*)(lds + wave * 8448);
    constexpr int I_IN = 16 * (NP / 32), I_UP1 = 8 * 32, I_OUT = 16 * 32;
    constexpr int NITEMS = I_IN + 4 * I_UP1 + I_OUT;
    for (int it = gw; it < NITEMS; it += ngw) {
        int r = it;
        if (r < I_IN) { transpose_item<true>(a.in(I_WIN) + (size_t)l * 1024 * NIN, 1024, NIN, (bf16_t*)(a.ws() + WS_WIN), scr, r / (NP / 32), r % (NP / 32), lane); continue; } r -= I_IN;
        if (r < 4 * I_UP1) { const int n = r / I_UP1; r %= I_UP1;
            transpose_item<false>(a.in(I_WUP) + ((size_t)l * 4 + n) * 512 * 1024, 512, 1024, (bf16_t*)(a.ws() + WS_WUP) + (size_t)n * 1024 * 512, scr, r / 32, r % 32, lane); continue; } r -= 4 * I_UP1;
        transpose_item<false>(a.in(I_WOUT) + (size_t)l * 1024 * 1024, 1024, 1024, (bf16_t*)(a.ws() + WS_WOUT), scr, r / 32, r % 32, lane);
    }
}
__device__ __forceinline__ void phase_rope(const KA a, int gtid, int nthr) {
    float* ct = (float*)(a.ws() + WS_ROPE); float* st = ct + 4096 * 32;
    for (int idx = gtid; idx < 4096 * 32; idx += nthr) { const int pos = idx >> 5, j = idx & 31;
        const double t = (double)pos * ROPE_INV_TURNS[j]; const float fr = (float)(t - floor(t));
        ct[idx] = __builtin_amdgcn_cosf(fr); st[idx] = __builtin_amdgcn_sinf(fr); }
}
__device__ __forceinline__ void phase_norm(const float* xsrc, const float* w, bf16_t* hb, int nrows, int gw, int ngw, int lane) {
    f32x4 wv[4];
#pragma unroll
    for (int j = 0; j < 4; ++j) wv[j] = ((const f32x4*)w)[lane + 64 * j];
    for (int m = gw; m < nrows; m += ngw) {
        const f32x4* xr = (const f32x4*)(xsrc + (size_t)m * D) + lane;
        f32x4 v[4]; float ss = 0.f;
#pragma unroll
        for (int j = 0; j < 4; ++j) { v[j] = xr[64 * j]; ss += (v[j].x * v[j].x + v[j].y * v[j].y) + (v[j].z * v[j].z + v[j].w * v[j].w); }
        const float r = 1.0f / sqrtf(wave_sum(ss) * (1.0f / D) + EPS);
        u32x2* o8 = (u32x2*)(hb + (size_t)m * D) + lane;
#pragma unroll
        for (int j = 0; j < 4; ++j) { u32x2 o; o.x = pk2(v[j].x * r * wv[j].x, v[j].y * r * wv[j].y); o.y = pk2(v[j].z * r * wv[j].z, v[j].w * r * wv[j].w); o8[64 * j] = o; }
    }
}
__device__ __forceinline__ void phase_final(float* x, const float* w, int nrows, int gw, int ngw, int lane) {
    f32x4 wv[4];
#pragma unroll
    for (int j = 0; j < 4; ++j) wv[j] = ((const f32x4*)w)[lane + 64 * j];
    for (int m = gw; m < nrows; m += ngw) {
        f32x4* xr = (f32x4*)(x + (size_t)m * D) + lane;
        f32x4 v[4]; float ss = 0.f;
#pragma unroll
        for (int j = 0; j < 4; ++j) { v[j] = xr[64 * j]; ss += (v[j].x * v[j].x + v[j].y * v[j].y) + (v[j].z * v[j].z + v[j].w * v[j].w); }
        const float r = 1.0f / sqrtf(wave_sum(ss) * (1.0f / D) + EPS);
#pragma unroll
        for (int j = 0; j < 4; ++j) xr[64 * j] = v[j] * r * wv[j];
    }
}

typedef short s16x4 __attribute__((ext_vector_type(4)));
__device__ __forceinline__ float logsig_f(float x) { return fminf(x, 0.f) - __logf(1.0f + __expf(-fabsf(x))); }
__device__ __forceinline__ float softplus_f(float x) { return fmaxf(x, 0.f) + __logf(1.0f + __expf(-fabsf(x))); }
__device__ __forceinline__ bf16x8 frag_tr(const LAS bf16_t* X, int ld, int idx0, int k0, int lane) {
    const LAS bf16_t* p = X + (k0 + 8 * (lane >> 4) + ((lane & 15) >> 2)) * ld + idx0 + 4 * (lane & 3);
    const s16x4 a = __builtin_amdgcn_ds_read_tr16_b64_v4i16((LAS s16x4*)p), b = __builtin_amdgcn_ds_read_tr16_b64_v4i16((LAS s16x4*)(p + 4 * ld));
    return (bf16x8){a[0], a[1], a[2], a[3], b[0], b[1], b[2], b[3]};
}
struct NormW { f32x4 w[4]; };
__device__ __forceinline__ void out128_tail(LAS unsigned char* lds, bf16_t* P, int colg, const NormW& nw, const u32x4 g0, const u32x4 g1, int tid) {
    const int lane = tid & 63, wave = __builtin_amdgcn_readfirstlane(tid >> 6);
    const LAS bf16_t* AM = (const LAS bf16_t*)(lds + OFF_AM); const LAS bf16_t* V = (const LAS bf16_t*)(lds + OFF_V); const LAS bf16_t* ST = (const LAS bf16_t*)(lds + OFF_ST);
    LAS float* O = (LAS float*)(lds + OFF_O);
    tile_mm<4, 8, 4>(wave, lane,
        [&](int m0, int ks) { return frag_kc(AM, 136, m0, ks * 32, lane); },
        [&](int n0, int ks) { return ks < 2 ? frag_tr(V, LDV, n0, ks * 32, lane) : frag_kc(ST, 72, n0, (ks - 2) * 32, lane); },
        [&](int t, int v0, const f32x4& acc) { *(LAS f32x4*)(O + t * 132 + v0) = acc; });
    __syncthreads();
    const int t = tid >> 3, sub = tid & 7;
    f32x4 o[4]; float ss = 0.f;
#pragma unroll
    for (int j = 0; j < 4; ++j) { o[j] = *(const LAS f32x4*)(O + t * 132 + sub * 16 + 4 * j); ss += (o[j].x * o[j].x + o[j].y * o[j].y) + (o[j].z * o[j].z + o[j].w * o[j].w); }
    ss += __shfl_xor(ss, 1); ss += __shfl_xor(ss, 2); ss += __shfl_xor(ss, 4);
    const float r = 1.0f / sqrtf(ss * (1.0f / 128.0f) + EPS);
    bf16_t* gp = P + (size_t)t * 512 + colg + sub * 16;
#pragma unroll
    for (int hh = 0; hh < 2; ++hh) {
        float g[8]; unpack8(hh == 0 ? g0 : g1, g);
        float res[8];
#pragma unroll
        for (int i = 0; i < 4; ++i) { res[i] = o[2 * hh][i] * r * nw.w[2 * hh][i] * siluf_(g[i]); res[4 + i] = o[2 * hh + 1][i] * r * nw.w[2 * hh + 1][i] * siluf_(g[4 + i]); }
        *(u32x4*)(gp + 8 * hh) = pack8(res);
    }
}
__device__ __forceinline__ void local128_tail(LAS unsigned char* lds, float* loc, int tid) {
    const int lane = tid & 63, wave = __builtin_amdgcn_readfirstlane(tid >> 6);
    const LAS bf16_t* V = (const LAS bf16_t*)(lds + OFF_V); const LAS bf16_t* KT = (const LAS bf16_t*)(lds + OFF_KT);
    tile_mm<8, 4, 2>(wave, lane,
        [&](int m0, int ks) { return frag_tr(V, LDV, m0, ks * 32, lane); },
        [&](int n0, int ks) { return frag_tr(KT, 72, n0, ks * 32, lane); },
        [&](int v, int k0, const f32x4& acc) { *(f32x4*)(loc + (size_t)v * 64 + k0) = acc; });
}
struct VsgPre { u32x4 v0, v1, s0, s1, g0, g1; };
template <int PH>
__device__ __forceinline__ void vsg_load(VsgPre& p, const bf16_t* P, int colv, int colg, const bf16_t* S, int tid) {
    p.v0 = *(const u32x4*)(P + (size_t)(tid >> 4) * PLD + colv + (tid & 15) * 8);
    p.v1 = *(const u32x4*)(P + (size_t)((tid >> 4) + 32) * PLD + colv + (tid & 15) * 8);
    if (PH == 3) { p.s0 = *(const u32x4*)(S + tid * 8); p.s1 = *(const u32x4*)(S + (tid + 512) * 8);
        const bf16_t* gp = P + (size_t)(tid >> 3) * PLD + colg + (tid & 7) * 16; p.g0 = *(const u32x4*)gp; p.g1 = *(const u32x4*)(gp + 8); }
}
template <int PH>
__device__ __forceinline__ void vsg_store(const VsgPre& p, LAS unsigned char* lds, int tid) {
    LAS bf16_t* V = (LAS bf16_t*)(lds + OFF_V); LAS bf16_t* ST = (LAS bf16_t*)(lds + OFF_ST);
    *(LAS u32x4*)(V + (tid >> 4) * LDV + (tid & 15) * 8) = p.v0; *(LAS u32x4*)(V + ((tid >> 4) + 32) * LDV + (tid & 15) * 8) = p.v1;
    if (PH == 3) { *(LAS u32x4*)(ST + (tid >> 3) * 72 + (tid & 7) * 8) = p.s0; *(LAS u32x4*)(ST + ((tid >> 3) + 64) * 72 + (tid & 7) * 8) = p.s1; }
}

struct GlPre { VsgPre vsg; u32x4 lr, q, k; float w0, w1, bk, x0, x1, x2, x3; unsigned short z[8]; };
template <int BR, int PH>
__device__ __forceinline__ void gl_load(GlPre& p, unsigned char* ws, const float* pa, const float* pb, int l, int u, int tid) {
    const int bl = u >> 8, h = (u >> 6) & 3, c = u & 63, lane = tid & 63, wave = __builtin_amdgcn_readfirstlane(tid >> 6);
    const bf16_t* P = (const bf16_t*)(ws + WS_PROJ) + (size_t)(bl * SEQ + c * 64) * PLD;
    constexpr int CQ = BR == 0 ? C_GQ : C_HQ, CK = BR == 0 ? C_GK : C_HF, CV = BR == 0 ? C_GV : C_HI, CG = BR == 0 ? C_GG : C_HG;
    if (BR == 0) {
        if (tid < 128) p.lr = *(const u32x4*)(P + (size_t)(tid >> 1) * PLD + C_LR + (tid & 1) * 8);
        p.w0 = pa[(size_t)l * 4096 + (tid >> 6) * 256 + h * 64 + lane]; p.w1 = pa[(size_t)l * 4096 + ((tid >> 6) + 8) * 256 + h * 64 + lane];
        p.bk = pb[l * 256 + h * 64 + lane];
    } else {
        const int ch = h * 64 + lane; p.x0 = pa[ch]; p.x1 = pa[256 + ch]; p.x2 = pa[512 + ch]; p.x3 = pa[768 + ch];
#pragma unroll
        for (int i = 0; i < 8; ++i) p.z[i] = P[(size_t)(wave * 8 + i) * PLD + CK + h * 64 + lane];
    }
    p.k = *(const u32x4*)(P + (size_t)(tid >> 3) * PLD + CK + h * 64 + (tid & 7) * 8);
    if (PH == 3) p.q = *(const u32x4*)(P + (size_t)(tid >> 3) * PLD + CQ + h * 64 + (tid & 7) * 8);
    vsg_load<PH>(p.vsg, P, CV + h * 128, CG + h * 128, (const bf16_t*)(ws + WS_STATE + BR * STATE_BR) + (size_t)((bl * 4 + h) * 64 + c) * 8192, tid);
}
template <int BR, int PH>
__device__ __forceinline__ void gl_compute(const GlPre& p, unsigned char* ws, LAS unsigned char* lds, const NormW& nw, int l, int u, int tid) {
    const int bl = u >> 8, h = (u >> 6) & 3, c = u & 63, lane = tid & 63, wave = __builtin_amdgcn_readfirstlane(tid >> 6);
    bf16_t* P = (bf16_t*)(ws + WS_PROJ) + (size_t)(bl * SEQ + c * 64) * PLD;
    LAS float* CUM = (LAS float*)(lds + OFF_CUM); LAS float* SEG = (LAS float*)(lds + OFF_SEG);
    LAS bf16_t* QT = (LAS bf16_t*)(lds + OFF_QT); LAS bf16_t* KT = (LAS bf16_t*)(lds + OFF_KT); LAS bf16_t* AM = (LAS bf16_t*)(lds + OFF_AM);
    constexpr int CG = BR == 0 ? C_GG : C_HG;
    const int bh = bl * 4 + h, k = lane;
    __syncthreads();
    float lgv[8];
    if (BR == 0) {
        LAS float* LRS = (LAS float*)(lds + OFF_O); LAS float* WLR = LRS + 64 * 17;
        if (tid < 128) { float f[8]; unpack8(p.lr, f);
#pragma unroll
            for (int i = 0; i < 8; ++i) LRS[(tid >> 1) * 17 + (tid & 1) * 8 + i] = f[i]; }
        WLR[tid] = p.w0; WLR[tid + 512] = p.w1;
        __syncthreads();
#pragma unroll
        for (int i = 0; i < 8; ++i) { const int t = wave * 8 + i; float x = p.bk;
#pragma unroll
            for (int r = 0; r < 16; ++r) x += LRS[t * 17 + r] * WLR[r * 64 + k];
            lgv[i] = logsig_f(x) * (1.0f / 16.0f); }
    } else {
        const float mx = fmaxf(fmaxf(p.x0, p.x1), fmaxf(p.x2, p.x3));
        const float e0 = __expf(p.x0 - mx), e1 = __expf(p.x1 - mx), e2 = __expf(p.x2 - mx), e3 = __expf(p.x3 - mx), inv = 1.0f / (e0 + e1 + e2 + e3);
        float lb = 0.f; if (l > 0) lb += e0 * inv; if (l > 1) lb += e1 * inv; if (l > 2) lb += e2 * inv;
        const float lbm = fmaxf(lb, 1e-30f), loglb = __logf(lbm);
        if (wave == 0) ((LAS float*)(lds + OFF_OML))[k] = 1.0f - lbm;
#pragma unroll
        for (int i = 0; i < 8; ++i) { const float z = bf2f(p.z[i]);
            const float a1 = logsig_f(z), a2 = loglb + logsig_f(-z); lgv[i] = fmaxf(a1, a2) + __logf(1.0f + __expf(-fabsf(a1 - a2))); }
    }
#pragma unroll
    for (int i = 1; i < 8; ++i) lgv[i] += lgv[i - 1];
    SEG[wave * 64 + k] = lgv[7];
    __syncthreads();
    float pre = 0.f;
    for (int w = 0; w < wave; ++w) pre += SEG[w * 64 + k];
#pragma unroll
    for (int i = 0; i < 8; ++i) CUM[(wave * 8 + i) * 68 + k] = lgv[i] + pre;
    vsg_store<PH>(p.vsg, lds, tid);
    __syncthreads();
    {
        const int t = tid >> 3, k8 = (tid & 7) * 8;
        float kk[8]; unpack8(p.k, kk);
        if (BR == 1) {
#pragma unroll
            for (int i = 0; i < 8; ++i) kk[i] = ((const LAS float*)(lds + OFF_OML))[k8 + i] / (1.0f + __expf(kk[i]));
        }
        const f32x4 c0 = *(const LAS f32x4*)(CUM + t * 68 + k8), c1 = *(const LAS f32x4*)(CUM + t * 68 + k8 + 4);
        const float ct[8] = {c0[0], c0[1], c0[2], c0[3], c1[0], c1[1], c1[2], c1[3]};
        if (PH == 3) {
            float q[8]; unpack8(p.q, q);
            const f32x4 m0 = *(const LAS f32x4*)(CUM + 31 * 68 + k8), m1 = *(const LAS f32x4*)(CUM + 31 * 68 + k8 + 4);
            const float cm[8] = {m0[0], m0[1], m0[2], m0[3], m1[0], m1[1], m1[2], m1[3]};
            const float qs = (BR == 0) ? 0.125f : 1.0f;
            float qt[8], kt[8], qh[8];
#pragma unroll
            for (int i = 0; i < 8; ++i) { const float d = clampf_(ct[i] - cm[i], -80.f, 80.f);
                qt[i] = q[i] * qs * __expf(d); kt[i] = kk[i] * __expf(-d); qh[i] = q[i] * qs * __expf(ct[i]); }
            *(LAS u32x4*)(QT + t * 72 + k8) = pack8(qt); *(LAS u32x4*)(KT + t * 72 + k8) = pack8(kt); *(LAS u32x4*)(AM + t * 136 + 64 + k8) = pack8(qh);
        } else {
            const f32x4 l0 = *(const LAS f32x4*)(CUM + 63 * 68 + k8), l1 = *(const LAS f32x4*)(CUM + 63 * 68 + k8 + 4);
            const float cl[8] = {l0[0], l0[1], l0[2], l0[3], l1[0], l1[1], l1[2], l1[3]};
            float kb[8];
#pragma unroll
            for (int i = 0; i < 8; ++i) kb[i] = kk[i] * __expf(cl[i] - ct[i]);
            *(LAS u32x4*)(KT + t * 72 + k8) = pack8(kb);
        }
    }
    __syncthreads();
    if (PH == 3) {
        tile_mm<4, 4, 2>(wave, lane,
            [&](int m0, int ks) { return frag_kc(QT, 72, m0, ks * 32, lane); },
            [&](int n0, int ks) { return frag_kc(KT, 72, n0, ks * 32, lane); },
            [&](int t, int s0, const f32x4& acc) { u32x2 w; w.x = pk2(s0 <= t ? acc[0] : 0.f, s0 + 1 <= t ? acc[1] : 0.f); w.y = pk2(s0 + 2 <= t ? acc[2] : 0.f, s0 + 3 <= t ? acc[3] : 0.f);
                *(LAS u32x2*)(AM + t * 136 + s0) = w; });
        __syncthreads();
        out128_tail(lds, (bf16_t*)(ws + WS_OUTN + BR * OUTN_BR) + (size_t)(bl * SEQ + c * 64) * 512, h * 128, nw, p.vsg.g0, p.vsg.g1, tid);
    } else {
        local128_tail(lds, (float*)(ws + WS_LOCAL + BR * LOCAL_BR) + (size_t)(bh * 64 + c) * 8192, tid);
        if (tid < 64) ((float*)(ws + WS_DEC + BR * DEC_BR))[(size_t)(bh * 64 + c) * 64 + tid] = __expf(CUM[63 * 68 + tid]);
    }
}

struct RetPre { VsgPre vsg; u32x2 k1, k2, q1, q2; f32x4 cs, sn; };
template <int PH>
__device__ __forceinline__ void ret_load(RetPre& p, unsigned char* ws, int u, int tid) {
    const int bl = u >> 8, h = (u >> 6) & 3, c = u & 63;
    const bf16_t* P = (const bf16_t*)(ws + WS_PROJ) + (size_t)(bl * SEQ + c * 64) * PLD;
    const int t = tid >> 3, j4 = (tid & 7) * 4, pos = c * 64 + t;
    const float* ctab = (const float*)(ws + WS_ROPE); const float* stab = ctab + 4096 * 32;
    p.cs = *(const f32x4*)(ctab + pos * 32 + j4); p.sn = *(const f32x4*)(stab + pos * 32 + j4);
    p.k1 = *(const u32x2*)(P + (size_t)t * PLD + C_RK + h * 64 + j4); p.k2 = *(const u32x2*)(P + (size_t)t * PLD + C_RK + h * 64 + 32 + j4);
    if (PH == 3) { p.q1 = *(const u32x2*)(P + (size_t)t * PLD + C_RQ + h * 64 + j4); p.q2 = *(const u32x2*)(P + (size_t)t * PLD + C_RQ + h * 64 + 32 + j4); }
    vsg_load<PH>(p.vsg, P, C_RV + h * 128, C_RG + h * 128, (const bf16_t*)(ws + WS_STATE + 2 * STATE_BR) + (size_t)((bl * 4 + h) * 64 + c) * 8192, tid);
}
template <int PH>
__device__ __forceinline__ void ret_compute(const RetPre& p, unsigned char* ws, LAS unsigned char* lds, const NormW& nw, int u, int tid) {
    const int bl = u >> 8, h = (u >> 6) & 3, c = u & 63, lane = tid & 63, wave = __builtin_amdgcn_readfirstlane(tid >> 6);
    bf16_t* P = (bf16_t*)(ws + WS_PROJ) + (size_t)(bl * SEQ + c * 64) * PLD;
    LAS bf16_t* QT = (LAS bf16_t*)(lds + OFF_QT); LAS bf16_t* KT = (LAS bf16_t*)(lds + OFF_KT); LAS bf16_t* AM = (LAS bf16_t*)(lds + OFF_AM);
    const int bh = bl * 4 + h;
    const float lg = __logf(1.0f - exp2f(-5.0f - (float)h));
    __syncthreads();
    {
        const int t = tid >> 3, j4 = (tid & 7) * 4;
        const f32x4 cs = p.cs, sn = p.sn;
        const float k1[4] = {bflo(p.k1.x), bfhi(p.k1.x), bflo(p.k1.y), bfhi(p.k1.y)}, k2[4] = {bflo(p.k2.x), bfhi(p.k2.x), bflo(p.k2.y), bfhi(p.k2.y)};
        float ka[4], kb[4];
#pragma unroll
        for (int i = 0; i < 4; ++i) { ka[i] = (k1[i] * cs[i] - k2[i] * sn[i]) * 0.125f; kb[i] = (k1[i] * sn[i] + k2[i] * cs[i]) * 0.125f; }
        if (PH == 3) {
            const float q1[4] = {bflo(p.q1.x), bfhi(p.q1.x), bflo(p.q1.y), bfhi(p.q1.y)}, q2[4] = {bflo(p.q2.x), bfhi(p.q2.x), bflo(p.q2.y), bfhi(p.q2.y)};
            float qa[4], qb[4];
#pragma unroll
            for (int i = 0; i < 4; ++i) { qa[i] = q1[i] * cs[i] - q2[i] * sn[i]; qb[i] = q1[i] * sn[i] + q2[i] * cs[i]; }
            const float gq = __expf(lg * (float)(t + 1));
            u32x2 w;
            w.x = pk2(qa[0], qa[1]); w.y = pk2(qa[2], qa[3]); *(LAS u32x2*)(QT + t * 72 + j4) = w;
            w.x = pk2(qb[0], qb[1]); w.y = pk2(qb[2], qb[3]); *(LAS u32x2*)(QT + t * 72 + 32 + j4) = w;
            w.x = pk2(ka[0], ka[1]); w.y = pk2(ka[2], ka[3]); *(LAS u32x2*)(KT + t * 72 + j4) = w;
            w.x = pk2(kb[0], kb[1]); w.y = pk2(kb[2], kb[3]); *(LAS u32x2*)(KT + t * 72 + 32 + j4) = w;
            w.x = pk2(qa[0] * gq, qa[1] * gq); w.y = pk2(qa[2] * gq, qa[3] * gq); *(LAS u32x2*)(AM + t * 136 + 64 + j4) = w;
            w.x = pk2(qb[0] * gq, qb[1] * gq); w.y = pk2(qb[2] * gq, qb[3] * gq); *(LAS u32x2*)(AM + t * 136 + 96 + j4) = w;
        } else {
            const float gk = __expf(lg * (float)(63 - t));
            u32x2 w;
            w.x = pk2(ka[0] * gk, ka[1] * gk); w.y = pk2(ka[2] * gk, ka[3] * gk); *(LAS u32x2*)(KT + t * 72 + j4) = w;
            w.x = pk2(kb[0] * gk, kb[1] * gk); w.y = pk2(kb[2] * gk, kb[3] * gk); *(LAS u32x2*)(KT + t * 72 + 32 + j4) = w;
        }
    }
    vsg_store<PH>(p.vsg, lds, tid);
    __syncthreads();
    if (PH == 3) {
        tile_mm<4, 4, 2>(wave, lane,
            [&](int m0, int ks) { return frag_kc(QT, 72, m0, ks * 32, lane); },
            [&](int n0, int ks) { return frag_kc(KT, 72, n0, ks * 32, lane); },
            [&](int t, int s0, const f32x4& acc) { float r[4];
#pragma unroll
                for (int j = 0; j < 4; ++j) r[j] = acc[j] * __expf(lg * fabsf((float)(t - s0 - j)));
                u32x2 w; w.x = pk2(r[0], r[1]); w.y = pk2(r[2], r[3]); *(LAS u32x2*)(AM + t * 136 + s0) = w; });
        __syncthreads();
        out128_tail(lds, (bf16_t*)(ws + WS_OUTN + 3 * OUTN_BR) + (size_t)(bl * SEQ + c * 64) * 512, h * 128, nw, p.vsg.g0, p.vsg.g1, tid);
    } else {
        local128_tail(lds, (float*)(ws + WS_LOCAL + 2 * LOCAL_BR) + (size_t)(bh * 64 + c) * 8192, tid);
        if (tid < 64) ((float*)(ws + WS_DEC + 2 * DEC_BR))[(size_t)(bh * 64 + c) * 64 + tid] = __expf(64.0f * lg);
    }
}

constexpr int OFF_XB = OFF_ST;
struct MambaPre { u32x4 xb[7]; f32x4 cw; u32x4 st[4]; u32x4 z[4]; unsigned short raw; float dtb, alog; };
__device__ __forceinline__ int mamba_gch(int g, int lc) { return lc < 256 ? g * 256 + lc : lc < 320 ? 512 + g * 64 + (lc - 256) : 640 + g * 64 + (lc - 320); }
template <int PH>
__device__ __forceinline__ void mamba_load(MambaPre& p, unsigned char* ws, const float* convw, const float* convb, const float* dtb, const float* alog, int l, int u, int tid) {
    const int bl = u >> 7, g = (u >> 6) & 1, c = u & 63, lane = tid & 63, wave = __builtin_amdgcn_readfirstlane(tid >> 6);
    const bf16_t* PB = (const bf16_t*)(ws + WS_PROJ);
    const bf16_t* P = PB + (size_t)(bl * SEQ + c * 64) * PLD;
    if (tid < 256) { const int hh = g * 4 + wave; p.raw = P[(size_t)lane * PLD + C_DT + hh]; p.dtb = dtb[l * 8 + hh]; p.alog = alog[l * 8 + hh]; }
#pragma unroll
    for (int j = 0; j < 7; ++j) { const int id = tid + 512 * j, r = id / 48, c8 = id % 48, pos = c * 64 + r - 3;
        p.xb[j] = (u32x4){0u, 0u, 0u, 0u};
        if (id < 67 * 48 && pos >= 0) p.xb[j] = *(const u32x4*)(PB + (size_t)(bl * SEQ + pos) * PLD + C_SX + mamba_gch(g, c8 * 8)); }
    if (tid < 480) { const int w = tid / 96, lc = (tid % 96) * 4;
        p.cw = (tid < 384) ? *(const f32x4*)(convw + (size_t)(l * 4 + w) * 768 + mamba_gch(g, lc)) : *(const f32x4*)(convb + l * 768 + mamba_gch(g, (tid - 384) * 4)); }
    if (PH == 3) {
#pragma unroll
        for (int e = 0; e < 4; ++e) p.st[e] = *(const u32x4*)((const bf16_t*)(ws + WS_STATE + 3 * STATE_BR) + (size_t)((bl * 8 + g * 4 + e) * 64 + c) * 4096 + tid * 8);
        const bf16_t* zp = P + (size_t)(tid >> 3) * PLD + C_SZ + g * 256 + (tid & 7) * 32;
#pragma unroll
        for (int j = 0; j < 4; ++j) p.z[j] = *(const u32x4*)(zp + 8 * j);
    }
}
template <int PH>
__device__ __forceinline__ void mamba_compute(const MambaPre& p, unsigned char* ws, LAS unsigned char* lds, const float* ssmd, const float* snorm, int l, int u, int tid) {
    const int bl = u >> 7, g = (u >> 6) & 1, c = u & 63, lane = tid & 63, wave = __builtin_amdgcn_readfirstlane(tid >> 6);
    bf16_t* P = (bf16_t*)(ws + WS_PROJ) + (size_t)(bl * SEQ + c * 64) * PLD;
    LAS float* DT = (LAS float*)(lds + OFF_SEG); LAS float* CH = DT + 256;
    LAS bf16_t* QT = (LAS bf16_t*)(lds + OFF_QT); LAS bf16_t* KT = (LAS bf16_t*)(lds + OFF_KT); LAS bf16_t* AM = (LAS bf16_t*)(lds + OFF_AM);
    LAS bf16_t* V = (LAS bf16_t*)(lds + OFF_V); LAS bf16_t* ST = (LAS bf16_t*)(lds + OFF_ST); LAS bf16_t* XB = (LAS bf16_t*)(lds + OFF_XB);
    LAS float* CW = (LAS float*)(lds + OFF_AM);
    __syncthreads();
    if (tid < 256) {
        const float dt = softplus_f(bf2f(p.raw) + p.dtb);
        float x = -__expf(p.alog) * dt;
#pragma unroll
        for (int off = 1; off < 64; off <<= 1) { const float y = __shfl_up(x, off); if (lane >= off) x += y; }
        DT[wave * 64 + lane] = dt; CH[wave * 64 + lane] = x;
    }
#pragma unroll
    for (int j = 0; j < 7; ++j) { const int id = tid + 512 * j; if (id < 67 * 48) *(LAS u32x4*)(XB + (id / 48) * 384 + (id % 48) * 8) = p.xb[j]; }
    if (tid < 480) *(LAS f32x4*)(CW + tid * 4) = p.cw;
    __syncthreads();
#pragma unroll 2
    for (int j = 0; j < 6; ++j) {
        const int id = tid + 512 * j, t = id / 48, c8 = id % 48;
        float acc[8];
        { const f32x4 b0 = *(const LAS f32x4*)(CW + 1536 + c8 * 8), b1 = *(const LAS f32x4*)(CW + 1536 + c8 * 8 + 4);
#pragma unroll
          for (int i = 0; i < 4; ++i) { acc[i] = b0[i]; acc[4 + i] = b1[i]; } }
#pragma unroll
        for (int w = 0; w < 4; ++w) { const u32x4 xw = *(const LAS u32x4*)(XB + (t + w) * 384 + c8 * 8); float xv[8]; unpack8(xw, xv);
            const f32x4 w0 = *(const LAS f32x4*)(CW + w * 384 + c8 * 8), w1 = *(const LAS f32x4*)(CW + w * 384 + c8 * 8 + 4);
#pragma unroll
            for (int i = 0; i < 4; ++i) { acc[i] += xv[i] * w0[i]; acc[4 + i] += xv[4 + i] * w1[i]; } }
#pragma unroll
        for (int i = 0; i < 8; ++i) acc[i] = siluf_(acc[i]);
        if (c8 < 32) {
            if (PH == 1) { const int e = c8 >> 3; const float wgt = DT[e * 64 + t] * __expf(CH[e * 64 + 63] - CH[e * 64 + t]);
#pragma unroll
                for (int i = 0; i < 8; ++i) acc[i] *= wgt; }
            *(LAS u32x4*)(V + t * LDV + c8 * 8) = pack8(acc);
        } else if (c8 < 40) *(LAS u32x4*)(KT + t * 72 + (c8 - 32) * 8) = pack8(acc);
        else *(LAS u32x4*)(QT + t * 72 + (c8 - 40) * 8) = pack8(acc);
    }
    __syncthreads();
    if (PH == 1) {
        float* loc = (float*)(ws + WS_LOCAL + 3 * LOCAL_BR);
        tile_mm<16, 4, 2>(wave, lane,
            [&](int m0, int ks) { return frag_tr(V, LDV, m0, ks * 32, lane); },
            [&](int n0, int ks) { return frag_tr(KT, 72, n0, ks * 32, lane); },
            [&](int hp, int m0, const f32x4& acc) { const int e = hp >> 6, pp = hp & 63; *(f32x4*)(loc + ((size_t)((bl * 8 + g * 4 + e) * 64 + c) * 64 + pp) * 64 + m0) = acc; });
        if (tid < 256) ((float*)(ws + WS_DEC + 3 * DEC_BR))[(size_t)((bl * 8 + g * 4 + wave) * 64 + c) * 64 + lane] = __expf(CH[wave * 64 + 63]);
    } else {
        LAS float* GS = (LAS float*)(lds + OFF_CUM);
        tile_mm<4, 4, 2>(wave, lane,
            [&](int m0, int ks) { return frag_kc(QT, 72, m0, ks * 32, lane); },
            [&](int n0, int ks) { return frag_kc(KT, 72, n0, ks * 32, lane); },
            [&](int t, int s0, const f32x4& acc) { *(LAS f32x4*)(GS + t * 68 + s0) = acc; });
        __syncthreads();
        LAS bf16_t* O16 = (LAS bf16_t*)(lds + OFF_O);
#pragma unroll
        for (int e = 0; e < 4; ++e) {
            const int hh = g * 4 + e;
            *(LAS u32x4*)(ST + (tid >> 3) * 72 + (tid & 7) * 8) = p.st[e];
            { const int t = tid >> 3, s8 = (tid & 7) * 8; const float cht = CH[e * 64 + t];
              const f32x4 g0 = *(const LAS f32x4*)(GS + t * 68 + s8), g1 = *(const LAS f32x4*)(GS + t * 68 + s8 + 4);
              const f32x4 h0 = *(const LAS f32x4*)(CH + e * 64 + s8), h1 = *(const LAS f32x4*)(CH + e * 64 + s8 + 4);
              const f32x4 d0 = *(const LAS f32x4*)(DT + e * 64 + s8), d1 = *(const LAS f32x4*)(DT + e * 64 + s8 + 4);
              float pv[8];
#pragma unroll
              for (int i = 0; i < 8; ++i) { const int s = s8 + i; const float gv = (i < 4) ? g0[i & 3] : g1[i & 3], hs = (i < 4) ? h0[i & 3] : h1[i & 3], ds = (i < 4) ? d0[i & 3] : d1[i & 3];
                  pv[i] = (s <= t) ? gv * __expf(cht - hs) * ds : 0.f; }
              *(LAS u32x4*)(AM + t * 136 + s8) = pack8(pv);
              const u32x4 cw = *(const LAS u32x4*)(QT + t * 72 + s8); float cv[8]; unpack8(cw, cv); const float ec = __expf(cht);
#pragma unroll
              for (int i = 0; i < 8; ++i) cv[i] *= ec;
              *(LAS u32x4*)(AM + t * 136 + 64 + s8) = pack8(cv); }
            __syncthreads();
            const float Dh = ssmd[l * 8 + hh];
            tile_mm<4, 4, 4>(wave, lane,
                [&](int m0, int ks) { return frag_kc(AM, 136, m0, ks * 32, lane); },
                [&](int n0, int ks) { return ks < 2 ? frag_tr(V + e * 64, LDV, n0, ks * 32, lane) : frag_kc(ST, 72, n0, (ks - 2) * 32, lane); },
                [&](int t, int p0, const f32x4& acc) {
                    const u32x2 xw = *(const LAS u32x2*)(V + t * LDV + e * 64 + p0);
                    u32x2 w; w.x = pk2(acc[0] + Dh * bflo(xw.x), acc[1] + Dh * bfhi(xw.x)); w.y = pk2(acc[2] + Dh * bflo(xw.y), acc[3] + Dh * bfhi(xw.y));
                    *(LAS u32x2*)(O16 + t * LDV + e * 64 + p0) = w; });
            __syncthreads();
        }
        const int t = tid >> 3, sub = tid & 7;
        float y[32]; float ss = 0.f;
#pragma unroll
        for (int j = 0; j < 4; ++j) { const u32x4 w = *(const LAS u32x4*)(O16 + t * LDV + sub * 32 + 8 * j); float f[8], zf[8]; unpack8(w, f); unpack8(p.z[j], zf);
#pragma unroll
            for (int i = 0; i < 8; ++i) { const float yy = f[i] * siluf_(zf[i]); y[8 * j + i] = yy; ss += yy * yy; } }
        ss += __shfl_xor(ss, 1); ss += __shfl_xor(ss, 2); ss += __shfl_xor(ss, 4);
        const float r = 1.0f / sqrtf(ss * (1.0f / 256.0f) + EPS);
        const float* nwp = snorm + l * 512 + g * 256 + sub * 32;
        bf16_t* op = (bf16_t*)(ws + WS_OUTN + 2 * OUTN_BR) + (size_t)(bl * SEQ + c * 64 + t) * 512 + g * 256 + sub * 32;
#pragma unroll
        for (int j = 0; j < 4; ++j) { const f32x4 w0 = *(const f32x4*)(nwp + 8 * j), w1 = *(const f32x4*)(nwp + 8 * j + 4); float res[8];
#pragma unroll
            for (int i = 0; i < 4; ++i) { res[i] = y[8 * j + i] * r * w0[i]; res[4 + i] = y[8 * j + 4 + i] * r * w1[i]; }
            *(u32x4*)(op + 8 * j) = pack8(res); }
    }
}

template <int PH>
__device__ __forceinline__ void phase_mixer(const KA a, LAS unsigned char* lds, int l, int tid) {
    const int G = gridDim.x, bid = blockIdx.x;
    unsigned char* ws = a.ws();
    for (int rep_ = 0; rep_ < ((PH == 3 && DUP_PHASE == 40) ? 2 : 1); ++rep_)
    {
        const float* convw = a.in(I_CONVW); const float* convb = a.in(I_CONVB); const float* dtb = a.in(I_DTB); const float* alog = a.in(I_ALOG); const float* ssmd = a.in(I_SSMD); const float* snorm = a.in(I_SNORM);
        MambaPre pre; int u = bid; if (u < 512) mamba_load<PH>(pre, ws, convw, convb, dtb, alog, l, u, tid);
        for (; u < 512; u += G) { const MambaPre cur = pre; if (u + G < 512) mamba_load<PH>(pre, ws, convw, convb, dtb, alog, l, u + G, tid); mamba_compute<PH>(cur, ws, lds, ssmd, snorm, l, u, tid); }
    }
    for (int rep_ = 0; rep_ < ((PH == 3 && DUP_PHASE == 41) ? 2 : 1); ++rep_)
    {
        const float* wlr = a.in(I_WLR); const float* blr = a.in(I_BLR); NormW nw;
        if (PH == 3) { const float* np = a.in(I_GNORM) + l * 128 + (tid & 7) * 16;
#pragma unroll
            for (int j = 0; j < 4; ++j) nw.w[j] = *(const f32x4*)(np + 4 * j); }
        GlPre pre; int u = bid; if (u < 1024) gl_load<0, PH>(pre, ws, wlr, blr, l, u, tid);
        for (; u < 1024; u += G) { const GlPre cur = pre; if (u + G < 1024) gl_load<0, PH>(pre, ws, wlr, blr, l, u + G, tid); gl_compute<0, PH>(cur, ws, lds, nw, l, u, tid); }
    }
    for (int rep_ = 0; rep_ < ((PH == 3 && DUP_PHASE == 42) ? 2 : 1); ++rep_)
    {
        const float* hlb = a.in(I_HLB); NormW nw;
        if (PH == 3) { const float* np = a.in(I_HNORM) + l * 128 + (tid & 7) * 16;
#pragma unroll
            for (int j = 0; j < 4; ++j) nw.w[j] = *(const f32x4*)(np + 4 * j); }
        GlPre pre; int u = bid; if (u < 1024) gl_load<1, PH>(pre, ws, hlb, hlb, l, u, tid);
        for (; u < 1024; u += G) { const GlPre cur = pre; if (u + G < 1024) gl_load<1, PH>(pre, ws, hlb, hlb, l, u + G, tid); gl_compute<1, PH>(cur, ws, lds, nw, l, u, tid); }
    }
    for (int rep_ = 0; rep_ < ((PH == 3 && DUP_PHASE == 43) ? 2 : 1); ++rep_)
    {
        NormW nw;
        if (PH == 3) { const float* np = a.in(I_RNORM) + l * 128 + (tid & 7) * 16;
#pragma unroll
            for (int j = 0; j < 4; ++j) nw.w[j] = *(const f32x4*)(np + 4 * j); }
        RetPre pre; int u = bid; if (u < 1024) ret_load<PH>(pre, ws, u, tid);
        for (; u < 1024; u += G) { const RetPre cur = pre; if (u + G < 1024) ret_load<PH>(pre, ws, u + G, tid); ret_compute<PH>(cur, ws, lds, nw, u, tid); }
    }
    __syncthreads();
}

__device__ __forceinline__ void phase_scan(const KA a, int tid) {
    const int nthr = gridDim.x * 512;
    for (int gt = blockIdx.x * 512 + tid; gt < 4 * 32768; gt += nthr) {
        const int br = gt >> 15, r = gt & 32767;
        const int E = (br == 3) ? 4096 : 8192;
        const int per = E / 4;
        const int bh = r / per, e4 = r % per, k0 = (e4 * 4) & 63;
        const float* loc = (const float*)(a.ws() + WS_LOCAL + br * LOCAL_BR) + (size_t)bh * 64 * E + e4 * 4;
        const float* dec = (const float*)(a.ws() + WS_DEC + br * DEC_BR) + (size_t)bh * 64 * 64 + k0;
        bf16_t* st = (bf16_t*)(a.ws() + WS_STATE + br * STATE_BR) + (size_t)bh * 64 * E + e4 * 4;
        f32x4 S = (f32x4){0.f, 0.f, 0.f, 0.f};
        for (int c0 = 0; c0 < 64; c0 += 8) {
            f32x4 L[8], Dv[8];
#pragma unroll
            for (int i = 0; i < 8; ++i) { L[i] = *(const f32x4*)(loc + (size_t)(c0 + i) * E); Dv[i] = *(const f32x4*)(dec + (c0 + i) * 64); }
#pragma unroll
            for (int i = 0; i < 8; ++i) { u32x2 w; w.x = pk2(S.x, S.y); w.y = pk2(S.z, S.w); *(u32x2*)(st + (size_t)(c0 + i) * E) = w; S = Dv[i] * S + L[i]; }
        }
    }
}

constexpr int NPH_PER = 7, NPHASE = DEPTH * 2 * NPH_PER + 1;
__global__ void __launch_bounds__(512, 2) fwd(Args ka) {
    extern __shared__ __attribute__((aligned(16))) unsigned char lds_raw[];
    LAS unsigned char* lds = (LAS unsigned char*)lds_raw;
    const int tid = threadIdx.x, lane = tid & 63, wave = __builtin_amdgcn_readfirstlane(tid >> 6);
    const int G = gridDim.x;
    const int gw = blockIdx.x * 8 + wave, ngw = G * 8;
    volatile LAS unsigned* MISC = (volatile LAS unsigned*)(lds + MISC_OFF);
    if (tid < 16) MISC[tid] = 0u;
    if (tid < 18) ((volatile LAS unsigned long long*)(lds + MISC_OFF + 64))[tid] = (unsigned long long)ka.in[tid];
    if (tid == 18) ((volatile LAS unsigned long long*)(lds + MISC_OFF + 64))[18] = (unsigned long long)ka.out;
    if (tid == 19) ((volatile LAS unsigned long long*)(lds + MISC_OFF + 64))[19] = (unsigned long long)ka.ws;
    __syncthreads();
    const KA a{lds};
    const int ph_lo = ka.ph_lo, ph_hi = ka.ph_hi, single = ka.single;
    XcdBarrier bar; bar.bar = (unsigned*)(ka.ws + WS_CTL); bar.x = 0; bar.st = MISC + 8;
    if (single) bar = xcd_barrier_post((unsigned*)(ka.ws + WS_CTL), MISC + 8);
#define IN(p) (ph_lo <= (p) && (p) < ph_hi)
#define GRID_BAR() do { if (single) xcd_barrier(bar); } while (0)
#define OPQ_TID() ({ int t__ = threadIdx.x; asm volatile("" : "+v"(t__)); t__; })
    for (int l = 0; l < DEPTH; ++l) {
        for (int hf = 0; hf < 2; ++hf) {
            const int pb = (l * 2 + hf) * NPH_PER;
            const size_t rowoff = (size_t)hf * MH;
            const float* xin = ((l == 0) ? a.in(I_X) : a.out()) + rowoff * D;
            float* xout = a.out() + rowoff * D;
            bf16_t* HB = (bf16_t*)(a.ws() + WS_HB);
            bf16_t* PROJ = (bf16_t*)(a.ws() + WS_PROJ);
            if (EN_N && IN(pb + 0)) {
                const int t_ = OPQ_TID(), lane_ = t_ & 63, wave_ = __builtin_amdgcn_readfirstlane(t_ >> 6), gw_ = blockIdx.x * 8 + wave_;
                if (hf == 0) { phase_weights(a, lds, l, gw_, ngw, wave_, lane_); if (l == 0) phase_rope(a, blockIdx.x * 512 + t_, G * 512); }
                phase_norm(xin, a.in(I_NORMW) + l * D, HB, MH, gw_, ngw, lane_);
                GRID_BAR();
            }
            if (EN_A && IN(pb + 1)) {
                pg8::Gemm g{HB, (const bf16_t*)(a.ws() + WS_WIN), MH, NP, D, D, D, 0, 0, 0}; pg8::StaticOrder S; S.init(MH, NP, G, (int)blockIdx.x);
                pg8::EpiProj E{PROJ, a.ws() + WS_GATES};
                pg8::gemm_phase<pg8::EpiProj, true>(lds, g, S, E, OPQ_TID());
                GRID_BAR();
            }
            if (EN_B1 && IN(pb + 2)) { phase_mixer<1>(a, lds, l, OPQ_TID()); GRID_BAR(); }
            if (EN_B2 && IN(pb + 3)) { phase_scan(a, OPQ_TID()); GRID_BAR(); }
            if (EN_B3 && IN(pb + 4)) { for (int rep = 0; rep < (DUP_PHASE == 4 ? 2 : 1); ++rep) phase_mixer<3>(a, lds, l, OPQ_TID()); GRID_BAR(); }
            if (EN_C && IN(pb + 5)) {
                pg8::Gemm g{(const bf16_t*)(a.ws() + WS_OUTN), (const bf16_t*)(a.ws() + WS_WUP), MH, D, 2048, 512, 512, 8, OUTN_BR, (size_t)1024 * 512 * 2}; pg8::StaticOrder S; S.init(MH, D, G, (int)blockIdx.x);
                pg8::EpiUp E{a.ws() + WS_GATES, HB};
                pg8::gemm_phase<pg8::EpiUp, false>(lds, g, S, E, OPQ_TID());
                GRID_BAR();
            }
            if (EN_D && IN(pb + 6)) {
                pg8::Gemm g{HB, (const bf16_t*)(a.ws() + WS_WOUT), MH, D, D, D, D, 0, 0, 0}; pg8::StaticOrder S; S.init(MH, D, G, (int)blockIdx.x);
                pg8::EpiOut E{xin, xout};
                pg8::gemm_phase<pg8::EpiOut, false>(lds, g, S, E, OPQ_TID());
                GRID_BAR();
            }
        }
    }
    if (IN(NPHASE - 1)) phase_final(a.out(), a.in(I_FNORM), BATCH * SEQ, gw, ngw, lane);
#undef IN
#undef GRID_BAR
}

extern "C" void kernel_launch(void* const* d_in, const int* in_sizes, int n_in, void* d_out, int out_size, void* d_ws, size_t ws_size, hipStream_t stream) {
    static int grid = 0;
    if (grid == 0) {
        if (n_in != 18 || in_sizes[0] != BATCH * SEQ * D || out_size != BATCH * SEQ * D || ws_size < WS_END) {
            fprintf(stderr, "kernel_launch: unexpected shapes (n_in %d, in0 %d, out %d, ws %zu, need %zu)\n", n_in, n_in > 0 ? in_sizes[0] : -1, out_size, ws_size, (size_t)WS_END); grid = -1; return; }
        int dev = 0, cus = 0, per_cu = 0;
        if (hipGetDevice(&dev) != hipSuccess || hipDeviceGetAttribute(&cus, hipDeviceAttributeMultiprocessorCount, dev) != hipSuccess) { grid = -1; return; }
        if (hipFuncSetAttribute((const void*)fwd, hipFuncAttributeMaxDynamicSharedMemorySize, LDS_BYTES) != hipSuccess) { fprintf(stderr, "kernel_launch: hipFuncSetAttribute failed\n"); grid = -1; return; }
        if (hipOccupancyMaxActiveBlocksPerMultiprocessor(&per_cu, (const void*)fwd, 512, LDS_BYTES) != hipSuccess || per_cu < 1)
            fprintf(stderr, "kernel_launch: occupancy query reports %d workgroups per CU\n", per_cu);
        (void)hipGetLastError();
        grid = cus;
    }
    if (grid < 0) return;
    (void)hipMemsetAsync((char*)d_ws + WS_CTL, 0, CTL_BYTES, stream);
    Args a{};
    for (int i = 0; i < 18; ++i) a.in[i] = (const float*)d_in[i];
    a.out = (float*)d_out; a.ws = (unsigned char*)d_ws; a.pad = 0;
#if MK_PER_PHASE_LAUNCH
    for (int p = 0; p < NPHASE; ++p) { a.ph_lo = p; a.ph_hi = p + 1; a.single = 0; hipLaunchKernelGGL(fwd, dim3(grid), dim3(512), LDS_BYTES, stream, a); }
#else
    a.ph_lo = 0; a.ph_hi = NPHASE; a.single = 1;
    hipLaunchKernelGGL(fwd, dim3(grid), dim3(512), LDS_BYTES, stream, a);
#endif
}
```

```cpp
#include <hip/hip_runtime.h>
#ifndef EN_N
#define EN_N 1
#define EN_A 1
#define EN_B1 1
#define EN_B2 1
#define EN_B3 1
#define EN_C 1
#define EN_D 1
#endif
#include <cstdio>
#include <cstdint>

#ifndef DUP_PHASE
#define DUP_PHASE -1
#endif
#ifndef MK_PER_PHASE_LAUNCH
#define MK_PER_PHASE_LAUNCH 0
#endif

#define LAS __attribute__((address_space(3)))
typedef unsigned short bf16_t;
typedef short bf16x8 __attribute__((ext_vector_type(8)));
typedef float f32x4 __attribute__((ext_vector_type(4)));
typedef unsigned u32x4 __attribute__((ext_vector_type(4)));
typedef unsigned u32x2 __attribute__((ext_vector_type(2)));

constexpr int D = 1024, BATCH = 8, SEQ = 4096, DEPTH = 4, NIN = 10008, NP = 10240, PLD = 6144;
constexpr int HBATCH = 4, MH = HBATCH * SEQ;
constexpr float EPS = 1e-6f;
constexpr int C_GQ = 0, C_GK = 256, C_GV = 512, C_GG = 1024, C_HQ = 1536, C_HF = 1792, C_HI = 2048, C_HG = 2560, C_SZ = 3072, C_SX = 3584,
              C_RQ = 4352, C_RK = 4608, C_RV = 4864, C_RG = 5376, C_LR = 5888, C_DT = 5904, C_MG = 6144;
__host__ __device__ __forceinline__ int origcol(int c) {
    if (c < 1024) return c;
    if (c < 4352) return c + 16;
    if (c < 5888) return c + 24;
    if (c < 5904) return c - 5888 + 1024;
    if (c < 5912) return c - 5904 + 4368;
    if (c < 6144) return -1;
    return c - 232;
}
enum { I_X = 0, I_NORMW, I_WIN, I_WLR, I_BLR, I_GNORM, I_HLB, I_HNORM, I_CONVW, I_CONVB, I_DTB, I_ALOG, I_SSMD, I_SNORM, I_RNORM, I_WUP, I_WOUT, I_FNORM };

constexpr size_t WS_CTL = 0, CTL_BYTES = 16384;
constexpr size_t WS_ROPE = 65536;
constexpr size_t WS_WIN = WS_ROPE + 2 * 4096 * 32 * 4;
constexpr size_t WS_WUP = WS_WIN + (size_t)NP * 1024 * 2;
constexpr size_t WS_WOUT = WS_WUP + (size_t)4 * 1024 * 512 * 2;
constexpr size_t WS_HB = WS_WOUT + (size_t)1024 * 1024 * 2;
constexpr size_t WS_PROJ = WS_HB + (size_t)MH * 1024 * 2;
constexpr size_t LOCAL_BR = (size_t)16 * 64 * 128 * 64 * 4;
constexpr size_t WS_GATES = WS_PROJ + (size_t)MH * PLD * 2;
constexpr size_t WS_LOCAL = WS_GATES + (size_t)MH * 4096;
constexpr size_t STATE_BR = LOCAL_BR / 2;
constexpr size_t WS_STATE = WS_LOCAL + 4 * LOCAL_BR;
constexpr size_t DEC_BR = (size_t)32 * 64 * 64 * 4;
constexpr size_t WS_DEC = WS_STATE + 4 * STATE_BR;
constexpr size_t WS_X16 = WS_DEC + 4 * DEC_BR;
constexpr size_t WS_RSQ = WS_X16 + (size_t)BATCH * SEQ * 1024 * 2;
constexpr size_t WS_RINV = WS_RSQ + (size_t)BATCH * SEQ * 16 * 4;
constexpr size_t WS_END = WS_RINV + (size_t)BATCH * SEQ * 4;
constexpr size_t WS_OUTN = WS_LOCAL;
constexpr size_t OUTN_BR = (size_t)MH * 512 * 2;

constexpr int LDS_BYTES = 147456;
constexpr int MISC_OFF = LDS_BYTES - 256;
constexpr int OFF_CUM = 0, OFF_SEG = 17408, OFF_QT = 19456, OFF_KT = 28672, OFF_AM = 37888, OFF_V = 55296, OFF_ST = 89088, OFF_O = 107520;
constexpr int LDV = 264;
constexpr int OFF_OML = 141312;

namespace pg8 {
constexpr int BM = 256, BK = 64, HALF = 128, HTB = HALF * BK * 2, STAGE_BYTES = 8 * HTB, NXCD = 8, WGM = 8;
__host__ __device__ __forceinline__ int lds_byte(int r, int c) { const int st = (r >> 4) * 2 + (c >> 5), rr = r & 15, cc = c & 31, ob = rr * 64 + cc * 2; return st * 1024 + (ob ^ (((ob >> 9) & 1) << 5)); }
__host__ __device__ __forceinline__ void stage_rc(int b, int& R, int& C) { const int st = b / 1024, sb = b % 1024, swz = sb ^ (((sb >> 9) & 1) << 5); R = (st >> 1) * 16 + swz / 64; C = (st & 1) * 32 + (swz % 64) / 2; }
__host__ __device__ __forceinline__ int perm32(int rho) { const int n = rho >> 4, i = rho & 15; return 8 * (i >> 2) + 4 * n + (i & 3); }
struct Unit { int pm, pn; };
struct Gemm { const bf16_t* A; const bf16_t* Bt; int M, N, K, lda, ldb; int kseg; size_t segA, segB; };
struct StaticOrder {
    int nM, nN, nwg, G, c;
    __host__ __device__ void init(int M, int N, int G_, int c_) { nM = M / BM; nN = N / BM; nwg = nM * nN; G = G_; c = c_; }
    __host__ __device__ bool next(int i, Unit& u) const {
        const long L = (long)i * G + c; if (L >= nwg) return false;
        int wgid = (int)L; { const int q = nwg / NXCD, r = nwg % NXCD, xcd = wgid % NXCD, off = wgid / NXCD; wgid = (xcd < r ? xcd * (q + 1) : r * (q + 1) + (xcd - r) * q) + off; }
        const int nig = WGM * nN, gid = wgid / nig, fm = gid * WGM, gsz = (nM - fm) < WGM ? (nM - fm) : WGM;
        u.pm = fm + ((wgid % nig) % gsz); u.pn = (wgid % nig) / gsz; return true;
    }
};
__device__ __forceinline__ unsigned cvt_pk_bf16(float lo, float hi) { unsigned r; asm volatile("v_cvt_pk_bf16_f32 %0, %1, %2" : "=v"(r) : "v"(lo), "v"(hi)); return r; }

struct EpiProj {
    static constexpr bool PERM = true, SEG = false;
    bf16_t* O; unsigned char* Gt; const float* Rinv;
    __device__ __forceinline__ void operator()(const f32x4 (&acc)[2][2][4][2], const Unit& u, int wr, int wc, int fr, int fq) const {
        const int row0 = u.pm * BM + wr * 64 + fr, col0 = u.pn * BM + wc * 32 + 8 * fq;
        const bool sig = u.pn >= 24;
        float rs[2][4];
#pragma unroll
        for (int ai = 0; ai < 2; ++ai)
#pragma unroll
            for (int m = 0; m < 4; ++m) rs[ai][m] = Rinv[row0 + ai * HALF + m * 16];
        unsigned char* gt = Gt + ((size_t)(u.pm * 16 + (u.pn - 24)) * 65536) + ((wr * 4 + wc) * 64 + fq * 16 + fr) * 8;
#pragma unroll
        for (int ai = 0; ai < 2; ++ai)
#pragma unroll
            for (int m = 0; m < 4; ++m) { bf16_t* rowp = O + (size_t)(row0 + ai * HALF + m * 16) * PLD + col0;
#pragma unroll
                for (int bj = 0; bj < 2; ++bj) { f32x4 v0 = acc[ai][bj][m][0] * rs[ai][m], v1 = acc[ai][bj][m][1] * rs[ai][m];
                    if (sig) {
#pragma unroll
                        for (int j = 0; j < 4; ++j) { v0[j] = __builtin_amdgcn_rcpf(1.0f + __expf(-v0[j])); v1[j] = __builtin_amdgcn_rcpf(1.0f + __expf(-v1[j])); } }
                    if (sig) { unsigned qv[8];
#pragma unroll
                        for (int j = 0; j < 4; ++j) { qv[j] = (unsigned)fminf(fmaxf(v0[j] * 255.0f + 0.5f, 1.0f), 255.0f); qv[4 + j] = (unsigned)fminf(fmaxf(v1[j] * 255.0f + 0.5f, 1.0f), 255.0f); }
                        u32x2 w8; w8.x = qv[0] | (qv[1] << 8) | (qv[2] << 16) | (qv[3] << 24); w8.y = qv[4] | (qv[5] << 8) | (qv[6] << 16) | (qv[7] << 24);
                        *(u32x2*)(gt + (size_t)(((ai * 4 + m) * 2 + bj) * 4096)) = w8; }
                    else { u32x4 w; w.x = cvt_pk_bf16(v0[0], v0[1]); w.y = cvt_pk_bf16(v0[2], v0[3]); w.z = cvt_pk_bf16(v1[0], v1[1]); w.w = cvt_pk_bf16(v1[2], v1[3]);
                        *(u32x4*)(rowp + bj * HALF) = w; } } }
    }
};
struct EpiUp {
    static constexpr bool PERM = true, SEG = true; static constexpr int KSEG = 8;
    const unsigned char* Gt; bf16_t* Mg;
    __device__ __forceinline__ void mid(f32x4 (&acc)[2][2][4][2], const Unit& u, int seg, int wr, int wc, int fr, int fq) const {
        const unsigned char* gpv = Gt + ((size_t)(u.pm * 16 + (seg - 1) * 4 + u.pn) * 65536) + ((wr * 4 + wc) * 64 + fq * 16 + fr) * 8;
#pragma unroll
        for (int ai = 0; ai < 2; ++ai)
#pragma unroll
            for (int mp = 0; mp < 2; ++mp) {
                u32x2 gp[2][2], gc[2][2];
#pragma unroll
                for (int mm = 0; mm < 2; ++mm)
#pragma unroll
                    for (int bj = 0; bj < 2; ++bj) { const unsigned char* q = gpv + (size_t)(((ai * 4 + mp * 2 + mm) * 2 + bj) * 4096); gp[mm][bj] = *(const u32x2*)q; gc[mm][bj] = *(const u32x2*)(q + 4 * 65536); }
#pragma unroll
                for (int mm = 0; mm < 2; ++mm)
#pragma unroll
                    for (int bj = 0; bj < 2; ++bj) { const int m = mp * 2 + mm;
#pragma unroll
                        for (int e = 0; e < 8; ++e) {
                            const float pv = (float)((gp[mm][bj][e >> 2] >> (8 * (e & 3))) & 0xffu), cv = (float)((gc[mm][bj][e >> 2] >> (8 * (e & 3))) & 0xffu);
                            acc[ai][bj][m][e >> 2][e & 3] *= pv * __builtin_amdgcn_rcpf(cv); } }
                asm volatile("" ::: "memory");
            }
    }
    __device__ __forceinline__ void operator()(const f32x4 (&acc)[2][2][4][2], const Unit& u, int wr, int wc, int fr, int fq) const {
        const int row0 = u.pm * BM + wr * 64 + fr, col0 = u.pn * BM + wc * 32 + 8 * fq;
        const unsigned char* gpv = Gt + ((size_t)(u.pm * 16 + 3 * 4 + u.pn) * 65536) + ((wr * 4 + wc) * 64 + fq * 16 + fr) * 8;
#pragma unroll
        for (int ai = 0; ai < 2; ++ai)
#pragma unroll
            for (int m = 0; m < 4; ++m) { const size_t r = (size_t)(row0 + ai * HALF + m * 16);
#pragma unroll
                for (int bj = 0; bj < 2; ++bj) { const int c = col0 + bj * HALF;
                    const u32x2 g = *(const u32x2*)(gpv + (size_t)(((ai * 4 + m) * 2 + bj) * 4096));
                    float res[8];
#pragma unroll
                    for (int e = 0; e < 8; ++e) res[e] = acc[ai][bj][m][e >> 2][e & 3] * ((float)((g[e >> 2] >> (8 * (e & 3))) & 0xffu) * (1.0f / 255.0f));
                    u32x4 w; w.x = cvt_pk_bf16(res[0], res[1]); w.y = cvt_pk_bf16(res[2], res[3]); w.z = cvt_pk_bf16(res[4], res[5]); w.w = cvt_pk_bf16(res[6], res[7]);
                    *(u32x4*)(Mg + r * 1024 + c) = w; } }
    }
};
struct EpiOut {
    static constexpr bool PERM = true, SEG = false;
    bf16_t* X; float* Rsq;
    __device__ __forceinline__ void operator()(const f32x4 (&acc)[2][2][4][2], const Unit& u, int wr, int wc, int fr, int fq) const {
        const int row0 = u.pm * BM + wr * 64 + fr, col0 = u.pn * BM + wc * 32 + 8 * fq;
#pragma unroll
        for (int ai = 0; ai < 2; ++ai)
#pragma unroll
            for (int m = 0; m < 4; ++m) { const size_t r = (size_t)(row0 + ai * HALF + m * 16); float ss = 0.f;
#pragma unroll
                for (int bj = 0; bj < 2; ++bj) { bf16_t* xp = X + r * 1024 + col0 + bj * HALF;
                    const u32x4 xo = *(const u32x4*)xp; float res[8];
#pragma unroll
                    for (int q = 0; q < 4; ++q) {
                        const float a0 = (q < 2) ? acc[ai][bj][m][0][2 * q] : acc[ai][bj][m][1][2 * q - 4], a1 = (q < 2) ? acc[ai][bj][m][0][2 * q + 1] : acc[ai][bj][m][1][2 * q - 3];
                        res[2 * q] = __builtin_bit_cast(float, xo[q] << 16) + a0; res[2 * q + 1] = __builtin_bit_cast(float, xo[q] & 0xffff0000u) + a1;
                        ss += res[2 * q] * res[2 * q] + res[2 * q + 1] * res[2 * q + 1]; }
                    u32x4 w; w.x = cvt_pk_bf16(res[0], res[1]); w.y = cvt_pk_bf16(res[2], res[3]); w.z = cvt_pk_bf16(res[4], res[5]); w.w = cvt_pk_bf16(res[6], res[7]);
                    *(u32x4*)xp = w; }
                ss += __shfl_xor(ss, 16); ss += __shfl_xor(ss, 32);
                if (fq == 0) Rsq[r * 16 + u.pn * 4 + wc] = ss; }
    }
};

template <class Epi, bool ALIGN_EPI>
__device__ __forceinline__ void gemm_phase(LAS unsigned char* lds, const Gemm g, const StaticOrder& S, const Epi& E, const int tid) {
    const int wid = __builtin_amdgcn_readfirstlane(tid >> 6), lane = tid & 63, wr = wid >> 2, wc = wid & 3, fr = lane & 15, fq = lane >> 4;
    const int K = g.K, nt = K / BK;
    unsigned voffA[2], voffB[2];
#pragma unroll
    for (int i = 0; i < 2; ++i) { int R, C; stage_rc(tid * 16 + i * 8192, R, C); const int Rb = Epi::PERM ? ((R & ~31) + perm32(R & 31)) : R;
        voffA[i] = (unsigned)(R * g.lda + C) * 2u; voffB[i] = (unsigned)(Rb * g.ldb + C) * 2u; }
    const size_t kstep = (size_t)(BK * 2);
    const size_t hstepA = (size_t)HALF * g.lda * 2, hstepB = (size_t)HALF * g.ldb * 2;
    const size_t tstepA = 2 * hstepA, tstepB = 2 * hstepB;
    const unsigned ldsw = (unsigned)wid * 1024u;
    const int aoff = lds_byte(wr * 64 + fr, fq * 8), boff = lds_byte(wc * 32 + fr, fq * 8);
#define PG8_SA(b, h) (((b) * 2 + (h)) * HTB)
#define PG8_SB(b, h) ((4 + (b) * 2 + (h)) * HTB)
#define PG8_STAGE(bufoff, gbase, voff) do { _Pragma("unroll") for (int _i = 0; _i < 2; ++_i) \
        __builtin_amdgcn_global_load_lds((const unsigned*)((const char*)(gbase) + (voff)[_i]), (LAS unsigned*)(lds + (bufoff) + ldsw + _i * 8192), 16, 0, 0); } while (0)
#define PG8_LDA(dst, b, h) do { _Pragma("unroll") for (int m = 0; m < 4; ++m) _Pragma("unroll") for (int k = 0; k < 2; ++k) dst[m][k] = *(const LAS bf16x8*)(lds + PG8_SA(b, h) + aoff + m * 2048 + k * 1024); } while (0)
#define PG8_LDB(dst, b, h) do { _Pragma("unroll") for (int n = 0; n < 2; ++n) _Pragma("unroll") for (int k = 0; k < 2; ++k) dst[n][k] = *(const LAS bf16x8*)(lds + PG8_SB(b, h) + boff + n * 2048 + k * 1024); } while (0)
#define PG8_MMA(ai, bj, At, Bt) do { __builtin_amdgcn_s_setprio(1); _Pragma("unroll") for (int m = 0; m < 4; ++m) _Pragma("unroll") for (int n = 0; n < 2; ++n) _Pragma("unroll") for (int k = 0; k < 2; ++k) \
        acc[ai][bj][m][n] = __builtin_amdgcn_mfma_f32_16x16x32_bf16(Bt[n][k], At[m][k], acc[ai][bj][m][n], 0, 0, 0); __builtin_amdgcn_s_setprio(0); } while (0)
#define PG8_WAIT_V(n) asm volatile("s_waitcnt vmcnt(" #n ")" ::: "memory")
#define PG8_WAIT_L(n) asm volatile("s_waitcnt lgkmcnt(" #n ")" ::: "memory")
#define PG8_BAR __builtin_amdgcn_s_barrier()
#define PG8_SCHED __builtin_amdgcn_sched_barrier(0)
    Unit cur, nxt; int ui = 0;
    if (!S.next(0, cur)) return;
    f32x4 acc[2][2][4][2];
#pragma unroll
    for (int a = 0; a < 2; ++a)
#pragma unroll
        for (int b = 0; b < 2; ++b)
#pragma unroll
            for (int m = 0; m < 4; ++m)
#pragma unroll
                for (int n = 0; n < 2; ++n) acc[a][b][m][n] = (f32x4){0.f, 0.f, 0.f, 0.f};
    bf16x8 At[4][2], B0[2][2], B1[2][2];
    const char* cA = (const char*)g.A + (size_t)cur.pm * tstepA; const char* cB = (const char*)g.Bt + (size_t)cur.pn * tstepB;
    PG8_STAGE(PG8_SB(0, 0), cB, voffB); PG8_STAGE(PG8_SB(0, 1), cB + hstepB, voffB); PG8_STAGE(PG8_SA(0, 0), cA, voffA); PG8_STAGE(PG8_SA(0, 1), cA + hstepA, voffA);
    if (wr == 1) PG8_BAR;
    PG8_WAIT_V(2); PG8_BAR;
    PG8_STAGE(PG8_SB(1, 0), cB + kstep, voffB); PG8_STAGE(PG8_SA(1, 0), cA + kstep, voffA); PG8_STAGE(PG8_SB(1, 1), cB + hstepB + kstep, voffB);
    PG8_WAIT_V(6); PG8_BAR;
    for (;;) {
        const bool has_next = S.next(ui + 1, nxt);
        const char* nA = has_next ? (const char*)g.A + (size_t)nxt.pm * tstepA : cA; const char* nB = has_next ? (const char*)g.Bt + (size_t)nxt.pn * tstepB : cB;
        for (int t = 0; t < nt; t += 2) {
            const bool last = (t == nt - 2);
            size_t oA1, oA2, oB2;
            if constexpr (Epi::SEG) { constexpr int KS = Epi::KSEG; const int s0 = t / KS, t0 = t % KS, s2 = (t + 2) / KS, t2 = (t + 2) % KS;
                oA1 = (size_t)s0 * g.segA + (size_t)(t0 + 1) * kstep; oA2 = (size_t)s2 * g.segA + (size_t)t2 * kstep; oB2 = (size_t)s2 * g.segB + (size_t)t2 * kstep;
                if (t0 == 0 && t > 0) { if (wr == 0) PG8_BAR; E.mid(acc, cur, s0, wr, wc, fr, fq); if (wr == 1) PG8_BAR; } }
            else { oA1 = (size_t)(t + 1) * kstep; oA2 = (size_t)(t + 2) * kstep; oB2 = oA2; }
            const char* a1 = cA + oA1;
            const char* a2 = last ? nA : cA + oA2; const char* b2 = last ? nB : cB + oB2;
            const char* a3 = a2 + kstep; const char* b3 = b2 + kstep;
            PG8_LDB(B0, 0, 0); PG8_LDB(B1, 0, 1); PG8_SCHED; PG8_LDA(At, 0, 0); PG8_STAGE(PG8_SA(1, 1), a1 + hstepA, voffA);
            PG8_WAIT_V(8); PG8_WAIT_L(0); PG8_BAR; PG8_MMA(0, 0, At, B0); PG8_MMA(0, 1, At, B1); PG8_BAR; PG8_SCHED;
            PG8_LDA(At, 0, 1); PG8_STAGE(PG8_SB(0, 0), b2, voffB); PG8_STAGE(PG8_SB(0, 1), b2 + hstepB, voffB); PG8_STAGE(PG8_SA(0, 0), a2, voffA);
            PG8_WAIT_V(8); PG8_WAIT_L(0); PG8_BAR; PG8_MMA(1, 0, At, B0); PG8_MMA(1, 1, At, B1); PG8_BAR; PG8_SCHED;
            PG8_LDB(B0, 1, 0); PG8_LDB(B1, 1, 1); PG8_SCHED; PG8_LDA(At, 1, 0); PG8_STAGE(PG8_SA(0, 1), a2 + hstepA, voffA);
            PG8_WAIT_V(8); PG8_WAIT_L(0); PG8_BAR; PG8_MMA(0, 0, At, B0); PG8_MMA(0, 1, At, B1); PG8_BAR; PG8_SCHED;
            PG8_LDA(At, 1, 1); PG8_STAGE(PG8_SB(1, 0), b3, voffB); PG8_STAGE(PG8_SB(1, 1), b3 + hstepB, voffB); PG8_STAGE(PG8_SA(1, 0), a3, voffA);
            PG8_WAIT_V(8); PG8_WAIT_L(0); PG8_BAR; PG8_MMA(1, 0, At, B0); PG8_MMA(1, 1, At, B1); PG8_BAR; PG8_SCHED;
        }
        if constexpr (ALIGN_EPI) { if (wr == 0) PG8_BAR; }
        E(acc, cur, wr, wc, fr, fq);
        if (!has_next) break;
#pragma unroll
        for (int a = 0; a < 2; ++a)
#pragma unroll
            for (int b = 0; b < 2; ++b)
#pragma unroll
                for (int m = 0; m < 4; ++m)
#pragma unroll
                    for (int n = 0; n < 2; ++n) acc[a][b][m][n] = (f32x4){0.f, 0.f, 0.f, 0.f};
        cur = nxt; cA = nA; cB = nB; ++ui;
        if constexpr (ALIGN_EPI) { if (wr == 1) PG8_BAR; }
    }
    PG8_WAIT_V(0);
    if constexpr (!ALIGN_EPI) { if (wr == 0) PG8_BAR; }
    PG8_BAR;
#undef PG8_SA
#undef PG8_SB
#undef PG8_STAGE
#undef PG8_LDA
#undef PG8_LDB
#undef PG8_MMA
#undef PG8_WAIT_V
#undef PG8_WAIT_L
#undef PG8_BAR
#undef PG8_SCHED
}
}

#define XB_TMO      128
#define XB_XCNT(j)  (256  + 64 * (j))
#define XB_XSUB(j)  (1280 + 64 * (j))
#define XB_XGEN(j)  (2304 + 64 * (j))
#define XB_TOP      3328
#define XB_TOPGEN   3392
#define XCD_BAR_WORDS 3456
#define XB_SPIN_CAP (1u << 18)
__device__ __forceinline__ unsigned xb_ld(unsigned* p)              { return __hip_atomic_load(p, __ATOMIC_RELAXED, __HIP_MEMORY_SCOPE_AGENT); }
__device__ __forceinline__ unsigned xb_add(unsigned* p, unsigned v) { return __hip_atomic_fetch_add(p, v, __ATOMIC_RELAXED, __HIP_MEMORY_SCOPE_AGENT); }
__device__ __forceinline__ unsigned xb_xcc_id() { return (unsigned)__builtin_amdgcn_s_getreg((3 << 11) | 20) & 0xFu; }
#define XB_SPIN(cond, bar) do { unsigned _sp = 0; while (cond) { __builtin_amdgcn_s_sleep(1); \
    if ((++_sp & 255u) == 0u) { if (xb_ld(&(bar)[XB_TMO])) break; if (_sp > XB_SPIN_CAP) { atomicAdd(&(bar)[XB_TMO], 1u); break; } } } } while (0)
struct XcdBarrier { unsigned* bar; unsigned x; volatile LAS unsigned* st; };
__device__ __forceinline__ XcdBarrier xcd_barrier_post(unsigned* bar, volatile LAS unsigned* st) {
    XcdBarrier b; b.bar = bar; b.x = xb_xcc_id(); b.st = st;
    if (threadIdx.x == 0) (void)xb_add(&bar[XB_XCNT(b.x)], 1u);
    return b;
}
__device__ __forceinline__ void xcd_barrier_complete(unsigned* bar, unsigned x, unsigned& nloc, unsigned& nx) {
    const unsigned G = gridDim.x * gridDim.y * gridDim.z;
    unsigned sum, cnt, mine, sp = 0u;
    for (;;) {
        sum = 0u; cnt = 0u;
        for (unsigned j = 0; j < 16; ++j) { const unsigned c = xb_ld(&bar[XB_XCNT(j)]); sum += c; cnt += (c > 0u) ? 1u : 0u; }
        mine = xb_ld(&bar[XB_XCNT(x)]);
        if (sum == G) break;
        __builtin_amdgcn_s_sleep(1);
        if ((++sp & 255u) == 0u) { if (xb_ld(&bar[XB_TMO])) break; if (sp > XB_SPIN_CAP) { atomicAdd(&bar[XB_TMO], 1u); break; } }
    }
    nloc = mine > 0u ? mine : 1u; nx = cnt > 0u ? cnt : 1u;
}
__device__ __forceinline__ void xcd_barrier(const XcdBarrier& b) {
    asm volatile("s_waitcnt vmcnt(0)" ::: "memory");
    __syncthreads();
    if (threadIdx.x == 0) {
        unsigned* bar = b.bar; asm volatile("" : "+s"(bar));
        __builtin_amdgcn_s_waitcnt(0);
        unsigned nloc = b.st[0], nx = b.st[1];
        if (nloc == 0u) { xcd_barrier_complete(bar, b.x, nloc, nx); b.st[0] = nloc; b.st[1] = nx; }
        const unsigned old = xb_add(&bar[XB_XSUB(b.x)], 1u);
        const unsigned gen = old / nloc;
        if (old + 1u == (gen + 1u) * nloc) {
            __builtin_amdgcn_fence(__ATOMIC_RELEASE, "agent");
            asm volatile("s_waitcnt vmcnt(0)" ::: "memory");
            const unsigned og = xb_add(&bar[XB_TOP], 1u);
            const unsigned tg = og / nx;
            if (og + 1u == (tg + 1u) * nx) xb_add(&bar[XB_TOPGEN], 1u);
            else XB_SPIN(xb_ld(&bar[XB_TOPGEN]) == tg, bar);
            __builtin_amdgcn_fence(__ATOMIC_ACQUIRE, "agent");
            xb_add(&bar[XB_XGEN(b.x)], 1u);
            asm volatile("s_waitcnt vmcnt(0)" ::: "memory");
        } else {
            XB_SPIN(xb_ld(&bar[XB_XGEN(b.x)]) == gen, bar);
            __builtin_amdgcn_fence(__ATOMIC_ACQUIRE, "agent");
            asm volatile("s_waitcnt vmcnt(0)" ::: "memory");
        }
    }
    __syncthreads();
}

#define LDS_WAIT() asm volatile("s_waitcnt lgkmcnt(0)" ::: "memory")
__device__ __forceinline__ float bf2f(unsigned short h) { return __builtin_bit_cast(float, (unsigned)h << 16); }
__device__ __forceinline__ float bflo(unsigned w) { return __builtin_bit_cast(float, w << 16); }
__device__ __forceinline__ float bfhi(unsigned w) { return __builtin_bit_cast(float, w & 0xffff0000u); }
__device__ __forceinline__ unsigned pk2(float lo, float hi) { return pg8::cvt_pk_bf16(lo, hi); }
__device__ __forceinline__ unsigned pk2_acc(float lo, float hi) {
    unsigned a = __builtin_bit_cast(unsigned, lo), b = __builtin_bit_cast(unsigned, hi);
    a += 0x7fffu + ((a >> 16) & 1u); b += 0x7fffu + ((b >> 16) & 1u); return (a >> 16) | (b & 0xffff0000u); }
__device__ __forceinline__ void unpack8(const u32x4 w, float (&f)[8]) {
#pragma unroll
    for (int q = 0; q < 4; ++q) { f[2 * q] = bflo(w[q]); f[2 * q + 1] = bfhi(w[q]); }
}
__device__ __forceinline__ u32x4 pack8(const float (&f)[8]) { u32x4 w; w.x = pk2(f[0], f[1]); w.y = pk2(f[2], f[3]); w.z = pk2(f[4], f[5]); w.w = pk2(f[6], f[7]); return w; }
__device__ __forceinline__ float wave_sum(float v) {
#pragma unroll
    for (int o = 1; o < 64; o <<= 1) v += __shfl_xor(v, o);
    return v;
}
__device__ __forceinline__ float logsig(float x) { return fminf(x, 0.f) - log1pf(expf(-fabsf(x))); }
__device__ __forceinline__ float softplusf_(float x) { return fmaxf(x, 0.f) + log1pf(expf(-fabsf(x))); }
__device__ __forceinline__ float siluf_(float x) { return x / (1.0f + __expf(-x)); }
__device__ __forceinline__ float clampf_(float x, float lo, float hi) { return fminf(fmaxf(x, lo), hi); }

__device__ const double ROPE_INV_TURNS[32] = {
    1.59154943091895346e-01, 1.19349369005342654e-01, 8.94994027620097804e-02, 6.71150846704077902e-02, 5.03292117661844479e-02, 3.77415881547067678e-02, 2.83021955739452893e-02, 2.12236531366118003e-02,
    1.59154945463488816e-02, 1.19349361890562274e-02, 8.94993956472293906e-03, 6.71150811130175919e-03, 5.03292153235746463e-03, 3.77415828186214788e-03, 2.83021961668436560e-03, 2.12236537295101661e-03,
    1.59154939534505145e-03, 1.19349373748529582e-03, 8.94994015762130509e-04, 6.71150796307716838e-04, 5.03292153235746485e-04, 3.77415865242362598e-04, 2.83021961668436560e-04, 2.12236529883872083e-04,
    1.59154950651349498e-04, 1.19349366337300012e-04, 8.94993978705982618e-05, 6.71150898212123409e-05, 5.03292153235746431e-05, 3.77415869874381108e-05, 2.83021957036418071e-05, 2.12236539147909035e-05};

struct Args { const float* in[18]; float* out; unsigned char* ws; int ph_lo, ph_hi, single, pad; };
struct KA {
    LAS unsigned char* lds;
    __device__ __forceinline__ unsigned long long ld(int i) const { volatile LAS unsigned* p = (volatile LAS unsigned*)(lds + MISC_OFF + 64) + 2 * i;
        const unsigned lo = __builtin_amdgcn_readfirstlane(p[0]), hi = __builtin_amdgcn_readfirstlane(p[1]); return ((unsigned long long)hi << 32) | lo; }
    __device__ __forceinline__ const float* in(int i) const { return (const float*)ld(i); }
    __device__ __forceinline__ float* out() const { return (float*)ld(18); }
    __device__ __forceinline__ unsigned char* ws() const { return (unsigned char*)ld(19); }
};

__device__ __forceinline__ bf16x8 frag_kc(const LAS bf16_t* X, int ld, int idx0, int k0, int lane) {
    return *(const LAS bf16x8*)(X + (idx0 + (lane & 15)) * ld + k0 + 8 * (lane >> 4));
}
__device__ __forceinline__ bf16x8 frag_ks(const LAS bf16_t* X, int ld, int idx0, int k0, int lane) {
    const LAS bf16_t* p = X + (k0 + 8 * (lane >> 4)) * ld + idx0 + (lane & 15);
    bf16x8 r;
#pragma unroll
    for (int i = 0; i < 8; ++i) r[i] = (short)p[i * ld];
    return r;
}
template <int MT, int NT, int KS, class FA, class FB, class EP>
__device__ __forceinline__ void tile_mm(int wave, int lane, FA&& fa, FB&& fb, EP&& epi) {
    for (int tix = wave; tix < MT * NT; tix += 8) {
        const int mt = tix % MT, nt = tix / MT;
        f32x4 acc = (f32x4){0.f, 0.f, 0.f, 0.f};
#pragma unroll
        for (int ks = 0; ks < KS; ++ks) { const bf16x8 av = fa(mt * 16, ks), bv = fb(nt * 16, ks); acc = __builtin_amdgcn_mfma_f32_16x16x32_bf16(bv, av, acc, 0, 0, 0); }
        epi(mt * 16 + (lane & 15), nt * 16 + 4 * (lane >> 4), acc);
    }
}

template <bool MAP>
__device__ __forceinline__ void transpose_item(const float* W, int K, int ldw, bf16_t* WT, LAS float* scr, int kb, int nb, int lane, const float* rowscale = nullptr) {
    const int k0 = 64 * kb, n0 = 32 * nb;
    int nsrc = n0 + (lane & 31); if (MAP) nsrc = origcol(nsrc);
#pragma unroll 8
    for (int i = 0; i < 32; ++i) { const int kk = 2 * i + (lane >> 5); float wv = (nsrc >= 0) ? W[(size_t)(k0 + kk) * ldw + nsrc] : 0.f; if (MAP) wv *= rowscale[k0 + kk]; scr[kk * 33 + (lane & 31)] = wv; }
    LDS_WAIT(); asm volatile("" ::: "memory");
    const int c = lane & 7;
#pragma unroll
    for (int j = 0; j < 4; ++j) { const int n = (lane >> 3) + 8 * j; const LAS float* s = scr + (8 * c) * 33 + n;
        u32x4 o; o.x = pk2(s[0 * 33], s[1 * 33]); o.y = pk2(s[2 * 33], s[3 * 33]); o.z = pk2(s[4 * 33], s[5 * 33]); o.w = pk2(s[6 * 33], s[7 * 33]);
        *(u32x4*)(WT + (size_t)(n0 + n) * K + k0 + 8 * c) = o; }
    LDS_WAIT(); asm volatile("" ::: "memory");
}
__device__ __forceinline__ void phase_weights(const KA a, LAS unsigned char* lds, int l, int gw, int ngw, int wave, int lane) {
    LAS float* scr = (LAS float*)(lds + wave * 8448);
    constexpr int I_IN = 16 * (NP / 32), I_UP1 = 8 * 32, I_OUT = 16 * 32;
    constexpr int NITEMS = I_IN + 4 * I_UP1 + I_OUT;
    for (int it = gw; it < NITEMS; it += ngw) {
        int r = it;
        if (r < I_IN) { transpose_item<true>(a.in(I_WIN) + (size_t)l * 1024 * NIN, 1024, NIN, (bf16_t*)(a.ws() + WS_WIN), scr, r / (NP / 32), r % (NP / 32), lane, a.in(I_NORMW) + l * D); continue; } r -= I_IN;
        if (r < 4 * I_UP1) { const int n = r / I_UP1; r %= I_UP1;
            transpose_item<false>(a.in(I_WUP) + ((size_t)l * 4 + n) * 512 * 1024, 512, 1024, (bf16_t*)(a.ws() + WS_WUP) + (size_t)n * 1024 * 512, scr, r / 32, r % 32, lane); continue; } r -= 4 * I_UP1;
        transpose_item<false>(a.in(I_WOUT) + (size_t)l * 1024 * 1024, 1024, 1024, (bf16_t*)(a.ws() + WS_WOUT), scr, r / 32, r % 32, lane);
    }
}
__device__ __forceinline__ void phase_rope(const KA a, int gtid, int nthr) {
    float* ct = (float*)(a.ws() + WS_ROPE); float* st = ct + 4096 * 32;
    for (int idx = gtid; idx < 4096 * 32; idx += nthr) { const int pos = idx >> 5, j = idx & 31;
        const double t = (double)pos * ROPE_INV_TURNS[j]; const float fr = (float)(t - floor(t));
        ct[idx] = __builtin_amdgcn_cosf(fr); st[idx] = __builtin_amdgcn_sinf(fr); }
}
__device__ __forceinline__ void phase_x_in(const float* xsrc, bf16_t* x16, float* rsq, float* rinv, int nrows, int gw, int ngw, int lane) {
    for (int m = gw; m < nrows; m += ngw) {
        const f32x4* xr = (const f32x4*)(xsrc + (size_t)m * D) + lane;
        f32x4 v[4]; float ss = 0.f;
#pragma unroll
        for (int j = 0; j < 4; ++j) { v[j] = xr[64 * j]; ss += (v[j].x * v[j].x + v[j].y * v[j].y) + (v[j].z * v[j].z + v[j].w * v[j].w); }
        ss = wave_sum(ss);
        u32x2* o8 = (u32x2*)(x16 + (size_t)m * D) + lane;
#pragma unroll
        for (int j = 0; j < 4; ++j) { u32x2 o; o.x = pk2(v[j].x, v[j].y); o.y = pk2(v[j].z, v[j].w); o8[64 * j] = o; }
        if (lane < 16) rsq[(size_t)m * 16 + lane] = (lane == 0) ? ss : 0.f;
        if (lane == 0) rinv[m] = 1.0f / sqrtf(ss * (1.0f / D) + EPS);
    }
}
__device__ __forceinline__ void phase_rinv(const float* rsq, float* rinv, int nrows, int gtid, int nthr) {
    for (int m = gtid; m < nrows; m += nthr) { const f32x4* rp = (const f32x4*)(rsq + (size_t)m * 16); const f32x4 s4 = (rp[0] + rp[1]) + (rp[2] + rp[3]);
        rinv[m] = 1.0f / sqrtf(((s4[0] + s4[1]) + (s4[2] + s4[3])) * (1.0f / D) + EPS); }
}
__device__ __forceinline__ void phase_final(const bf16_t* x16, float* out, const float* w, int nrows, int gw, int ngw, int lane) {
    f32x4 wv[4];
#pragma unroll
    for (int j = 0; j < 4; ++j) wv[j] = ((const f32x4*)w)[lane * 4 + j];
    for (int m = gw; m < nrows; m += ngw) {
        const u32x4* xr = (const u32x4*)(x16 + (size_t)m * D) + lane * 2;
        float f[16]; { float t8[8]; unpack8(xr[0], t8);
#pragma unroll
            for (int i = 0; i < 8; ++i) f[i] = t8[i]; unpack8(xr[1], t8);
#pragma unroll
            for (int i = 0; i < 8; ++i) f[8 + i] = t8[i]; }
        float ss = 0.f;
#pragma unroll
        for (int i = 0; i < 16; ++i) ss += f[i] * f[i];
        const float r = 1.0f / sqrtf(wave_sum(ss) * (1.0f / D) + EPS);
        f32x4* orow = (f32x4*)(out + (size_t)m * D) + lane * 4;
#pragma unroll
        for (int j = 0; j < 4; ++j) orow[j] = (f32x4){f[4 * j], f[4 * j + 1], f[4 * j + 2], f[4 * j + 3]} * r * wv[j];
    }
}

typedef short s16x4 __attribute__((ext_vector_type(4)));
__device__ __forceinline__ float logsig_f(float x) { return fminf(x, 0.f) - __logf(1.0f + __expf(-fabsf(x))); }
__device__ __forceinline__ float softplus_f(float x) { return fmaxf(x, 0.f) + __logf(1.0f + __expf(-fabsf(x))); }
__device__ __forceinline__ bf16x8 frag_tr(const LAS bf16_t* X, int ld, int idx0, int k0, int lane) {
    const LAS bf16_t* p = X + (k0 + 8 * (lane >> 4) + ((lane & 15) >> 2)) * ld + idx0 + 4 * (lane & 3);
    const s16x4 a = __builtin_amdgcn_ds_read_tr16_b64_v4i16((LAS s16x4*)p), b = __builtin_amdgcn_ds_read_tr16_b64_v4i16((LAS s16x4*)(p + 4 * ld));
    return (bf16x8){a[0], a[1], a[2], a[3], b[0], b[1], b[2], b[3]};
}
struct NormW { f32x4 w[4]; };
__device__ __forceinline__ void out128_tail(LAS unsigned char* lds, bf16_t* P, int colg, const NormW& nw, const u32x4 g0, const u32x4 g1, int tid) {
    const int lane = tid & 63, wave = __builtin_amdgcn_readfirstlane(tid >> 6);
    const LAS bf16_t* AM = (const LAS bf16_t*)(lds + OFF_AM); const LAS bf16_t* V = (const LAS bf16_t*)(lds + OFF_V); const LAS bf16_t* ST = (const LAS bf16_t*)(lds + OFF_ST);
    LAS float* O = (LAS float*)(lds + OFF_O);
    tile_mm<4, 8, 4>(wave, lane,
        [&](int m0, int ks) { return frag_kc(AM, 136, m0, ks * 32, lane); },
        [&](int n0, int ks) { return ks < 2 ? frag_tr(V, LDV, n0, ks * 32, lane) : frag_kc(ST, 72, n0, (ks - 2) * 32, lane); },
        [&](int t, int v0, const f32x4& acc) { *(LAS f32x4*)(O + t * 132 + v0) = acc; });
    __syncthreads();
    const int t = tid >> 3, sub = tid & 7;
    f32x4 o[4]; float ss = 0.f;
#pragma unroll
    for (int j = 0; j < 4; ++j) { o[j] = *(const LAS f32x4*)(O + t * 132 + sub * 16 + 4 * j); ss += (o[j].x * o[j].x + o[j].y * o[j].y) + (o[j].z * o[j].z + o[j].w * o[j].w); }
    ss += __shfl_xor(ss, 1); ss += __shfl_xor(ss, 2); ss += __shfl_xor(ss, 4);
    const float r = 1.0f / sqrtf(ss * (1.0f / 128.0f) + EPS);
    bf16_t* gp = P + (size_t)t * 512 + colg + sub * 16;
#pragma unroll
    for (int hh = 0; hh < 2; ++hh) {
        float g[8]; unpack8(hh == 0 ? g0 : g1, g);
        float res[8];
#pragma unroll
        for (int i = 0; i < 4; ++i) { res[i] = o[2 * hh][i] * r * nw.w[2 * hh][i] * siluf_(g[i]); res[4 + i] = o[2 * hh + 1][i] * r * nw.w[2 * hh + 1][i] * siluf_(g[4 + i]); }
        *(u32x4*)(gp + 8 * hh) = pack8(res);
    }
}
__device__ __forceinline__ void local128_tail(LAS unsigned char* lds, bf16_t* loc, int tid) {
    const int lane = tid & 63, wave = __builtin_amdgcn_readfirstlane(tid >> 6);
    const LAS bf16_t* V = (const LAS bf16_t*)(lds + OFF_V); const LAS bf16_t* KT = (const LAS bf16_t*)(lds + OFF_KT);
    tile_mm<8, 4, 2>(wave, lane,
        [&](int m0, int ks) { return frag_tr(V, LDV, m0, ks * 32, lane); },
        [&](int n0, int ks) { return frag_tr(KT, 72, n0, ks * 32, lane); },
        [&](int v, int k0, const f32x4& acc) { u32x2 w; w.x = pk2_acc(acc[0], acc[1]); w.y = pk2_acc(acc[2], acc[3]); *(u32x2*)(loc + (size_t)v * 64 + k0) = w; });
}
struct VsgPre { u32x4 v0, v1, s0, s1, g0, g1; };
template <int PH>
__device__ __forceinline__ void vsg_load(VsgPre& p, const bf16_t* P, int colv, int colg, const bf16_t* S, int tid) {
    p.v0 = *(const u32x4*)(P + (size_t)(tid >> 4) * PLD + colv + (tid & 15) * 8);
    p.v1 = *(const u32x4*)(P + (size_t)((tid >> 4) + 32) * PLD + colv + (tid & 15) * 8);
    if (PH == 3) { p.s0 = *(const u32x4*)(S + tid * 8); p.s1 = *(const u32x4*)(S + (tid + 512) * 8);
        const bf16_t* gp = P + (size_t)(tid >> 3) * PLD + colg + (tid & 7) * 16; p.g0 = *(const u32x4*)gp; p.g1 = *(const u32x4*)(gp + 8); }
}
template <int PH>
__device__ __forceinline__ void vsg_store(const VsgPre& p, LAS unsigned char* lds, int tid) {
    LAS bf16_t* V = (LAS bf16_t*)(lds + OFF_V); LAS bf16_t* ST = (LAS bf16_t*)(lds + OFF_ST);
    *(LAS u32x4*)(V + (tid >> 4) * LDV + (tid & 15) * 8) = p.v0; *(LAS u32x4*)(V + ((tid >> 4) + 32) * LDV + (tid & 15) * 8) = p.v1;
    if (PH == 3) { *(LAS u32x4*)(ST + (tid >> 3) * 72 + (tid & 7) * 8) = p.s0; *(LAS u32x4*)(ST + ((tid >> 3) + 64) * 72 + (tid & 7) * 8) = p.s1; }
}

struct GlPre { VsgPre vsg; u32x4 lr, q, k; float w0, w1, bk, x0, x1, x2, x3; unsigned short z[8]; };
template <int BR, int PH>
__device__ __forceinline__ void gl_load(GlPre& p, unsigned char* ws, const float* pa, const float* pb, int l, int u, int tid) {
    const int bl = u >> 8, h = (u >> 6) & 3, c = u & 63, lane = tid & 63, wave = __builtin_amdgcn_readfirstlane(tid >> 6);
    const bf16_t* P = (const bf16_t*)(ws + WS_PROJ) + (size_t)(bl * SEQ + c * 64) * PLD;
    constexpr int CQ = BR == 0 ? C_GQ : C_HQ, CK = BR == 0 ? C_GK : C_HF, CV = BR == 0 ? C_GV : C_HI, CG = BR == 0 ? C_GG : C_HG;
    if (BR == 0) {
        if (tid < 128) p.lr = *(const u32x4*)(P + (size_t)(tid >> 1) * PLD + C_LR + (tid & 1) * 8);
        p.w0 = pa[(size_t)l * 4096 + (tid >> 6) * 256 + h * 64 + lane]; p.w1 = pa[(size_t)l * 4096 + ((tid >> 6) + 8) * 256 + h * 64 + lane];
        p.bk = pb[l * 256 + h * 64 + lane];
    } else {
        const int ch = h * 64 + lane; p.x0 = pa[ch]; p.x1 = pa[256 + ch]; p.x2 = pa[512 + ch]; p.x3 = pa[768 + ch];
#pragma unroll
        for (int i = 0; i < 8; ++i) p.z[i] = P[(size_t)(wave * 8 + i) * PLD + CK + h * 64 + lane];
    }
    p.k = *(const u32x4*)(P + (size_t)(tid >> 3) * PLD + CK + h * 64 + (tid & 7) * 8);
    if (PH == 3) p.q = *(const u32x4*)(P + (size_t)(tid >> 3) * PLD + CQ + h * 64 + (tid & 7) * 8);
    vsg_load<PH>(p.vsg, P, CV + h * 128, CG + h * 128, (const bf16_t*)(ws + WS_STATE + BR * STATE_BR) + (size_t)((bl * 4 + h) * 64 + c) * 8192, tid);
}
template <int BR, int PH>
__device__ __forceinline__ void gl_compute(const GlPre& p, unsigned char* ws, LAS unsigned char* lds, const NormW& nw, int l, int u, int tid) {
    const int bl = u >> 8, h = (u >> 6) & 3, c = u & 63, lane = tid & 63, wave = __builtin_amdgcn_readfirstlane(tid >> 6);
    bf16_t* P = (bf16_t*)(ws + WS_PROJ) + (size_t)(bl * SEQ + c * 64) * PLD;
    LAS float* CUM = (LAS float*)(lds + OFF_CUM); LAS float* SEG = (LAS float*)(lds + OFF_SEG);
    LAS bf16_t* QT = (LAS bf16_t*)(lds + OFF_QT); LAS bf16_t* KT = (LAS bf16_t*)(lds + OFF_KT); LAS bf16_t* AM = (LAS bf16_t*)(lds + OFF_AM);
    constexpr int CG = BR == 0 ? C_GG : C_HG;
    const int bh = bl * 4 + h, k = lane;
    __syncthreads();
    float lgv[8];
    if (BR == 0) {
        LAS float* LRS = (LAS float*)(lds + OFF_O); LAS float* WLR = LRS + 64 * 17;
        if (tid < 128) { float f[8]; unpack8(p.lr, f);
#pragma unroll
            for (int i = 0; i < 8; ++i) LRS[(tid >> 1) * 17 + (tid & 1) * 8 + i] = f[i]; }
        WLR[tid] = p.w0; WLR[tid + 512] = p.w1;
        __syncthreads();
#pragma unroll
        for (int i = 0; i < 8; ++i) { const int t = wave * 8 + i; float x = p.bk;
#pragma unroll
            for (int r = 0; r < 16; ++r) x += LRS[t * 17 + r] * WLR[r * 64 + k];
            lgv[i] = logsig_f(x) * (1.0f / 16.0f); }
    } else {
        const float mx = fmaxf(fmaxf(p.x0, p.x1), fmaxf(p.x2, p.x3));
        const float e0 = __expf(p.x0 - mx), e1 = __expf(p.x1 - mx), e2 = __expf(p.x2 - mx), e3 = __expf(p.x3 - mx), inv = 1.0f / (e0 + e1 + e2 + e3);
        float lb = 0.f; if (l > 0) lb += e0 * inv; if (l > 1) lb += e1 * inv; if (l > 2) lb += e2 * inv;
        const float lbm = fmaxf(lb, 1e-30f), loglb = __logf(lbm);
        if (wave == 0) ((LAS float*)(lds + OFF_OML))[k] = 1.0f - lbm;
#pragma unroll
        for (int i = 0; i < 8; ++i) { const float z = bf2f(p.z[i]);
            const float a1 = logsig_f(z), a2 = loglb + logsig_f(-z); lgv[i] = fmaxf(a1, a2) + __logf(1.0f + __expf(-fabsf(a1 - a2))); }
    }
#pragma unroll
    for (int i = 1; i < 8; ++i) lgv[i] += lgv[i - 1];
    SEG[wave * 64 + k] = lgv[7];
    __syncthreads();
    float pre = 0.f;
    for (int w = 0; w < wave; ++w) pre += SEG[w * 64 + k];
#pragma unroll
    for (int i = 0; i < 8; ++i) CUM[(wave * 8 + i) * 68 + k] = lgv[i] + pre;
    vsg_store<PH>(p.vsg, lds, tid);
    __syncthreads();
    {
        const int t = tid >> 3, k8 = (tid & 7) * 8;
        float kk[8]; unpack8(p.k, kk);
        if (BR == 1) {
#pragma unroll
            for (int i = 0; i < 8; ++i) kk[i] = ((const LAS float*)(lds + OFF_OML))[k8 + i] / (1.0f + __expf(kk[i]));
        }
        const f32x4 c0 = *(const LAS f32x4*)(CUM + t * 68 + k8), c1 = *(const LAS f32x4*)(CUM + t * 68 + k8 + 4);
        const float ct[8] = {c0[0], c0[1], c0[2], c0[3], c1[0], c1[1], c1[2], c1[3]};
        if (PH == 3) {
            float q[8]; unpack8(p.q, q);
            const f32x4 m0 = *(const LAS f32x4*)(CUM + 31 * 68 + k8), m1 = *(const LAS f32x4*)(CUM + 31 * 68 + k8 + 4);
            const float cm[8] = {m0[0], m0[1], m0[2], m0[3], m1[0], m1[1], m1[2], m1[3]};
            const float qs = (BR == 0) ? 0.125f : 1.0f;
            float qt[8], kt[8], qh[8];
#pragma unroll
            for (int i = 0; i < 8; ++i) { const float d = clampf_(ct[i] - cm[i], -80.f, 80.f);
                qt[i] = q[i] * qs * __expf(d); kt[i] = kk[i] * __expf(-d); qh[i] = q[i] * qs * __expf(ct[i]); }
            *(LAS u32x4*)(QT + t * 72 + k8) = pack8(qt); *(LAS u32x4*)(KT + t * 72 + k8) = pack8(kt); *(LAS u32x4*)(AM + t * 136 + 64 + k8) = pack8(qh);
        } else {
            const f32x4 l0 = *(const LAS f32x4*)(CUM + 63 * 68 + k8), l1 = *(const LAS f32x4*)(CUM + 63 * 68 + k8 + 4);
            const float cl[8] = {l0[0], l0[1], l0[2], l0[3], l1[0], l1[1], l1[2], l1[3]};
            float kb[8];
#pragma unroll
            for (int i = 0; i < 8; ++i) kb[i] = kk[i] * __expf(cl[i] - ct[i]);
            *(LAS u32x4*)(KT + t * 72 + k8) = pack8(kb);
        }
    }
    __syncthreads();
    if (PH == 3) {
        tile_mm<4, 4, 2>(wave, lane,
            [&](int m0, int ks) { return frag_kc(QT, 72, m0, ks * 32, lane); },
            [&](int n0, int ks) { return frag_kc(KT, 72, n0, ks * 32, lane); },
            [&](int t, int s0, const f32x4& acc) { u32x2 w; w.x = pk2(s0 <= t ? acc[0] : 0.f, s0 + 1 <= t ? acc[1] : 0.f); w.y = pk2(s0 + 2 <= t ? acc[2] : 0.f, s0 + 3 <= t ? acc[3] : 0.f);
                *(LAS u32x2*)(AM + t * 136 + s0) = w; });
        __syncthreads();
        out128_tail(lds, (bf16_t*)(ws + WS_OUTN + BR * OUTN_BR) + (size_t)(bl * SEQ + c * 64) * 512, h * 128, nw, p.vsg.g0, p.vsg.g1, tid);
    } else {
        local128_tail(lds, (bf16_t*)(ws + WS_LOCAL + BR * LOCAL_BR) + (size_t)(bh * 64 + c) * 8192, tid);
        if (tid < 64) ((float*)(ws + WS_DEC + BR * DEC_BR))[(size_t)(bh * 64 + c) * 64 + tid] = __expf(CUM[63 * 68 + tid]);
    }
}

struct RetPre { VsgPre vsg; u32x2 k1, k2, q1, q2; f32x4 cs, sn; };
template <int PH>
__device__ __forceinline__ void ret_load(RetPre& p, unsigned char* ws, int u, int tid) {
    const int bl = u >> 8, h = (u >> 6) & 3, c = u & 63;
    const bf16_t* P = (const bf16_t*)(ws + WS_PROJ) + (size_t)(bl * SEQ + c * 64) * PLD;
    const int t = tid >> 3, j4 = (tid & 7) * 4, pos = c * 64 + t;
    const float* ctab = (const float*)(ws + WS_ROPE); const float* stab = ctab + 4096 * 32;
    p.cs = *(const f32x4*)(ctab + pos * 32 + j4); p.sn = *(const f32x4*)(stab + pos * 32 + j4);
    p.k1 = *(const u32x2*)(P + (size_t)t * PLD + C_RK + h * 64 + j4); p.k2 = *(const u32x2*)(P + (size_t)t * PLD + C_RK + h * 64 + 32 + j4);
    if (PH == 3) { p.q1 = *(const u32x2*)(P + (size_t)t * PLD + C_RQ + h * 64 + j4); p.q2 = *(const u32x2*)(P + (size_t)t * PLD + C_RQ + h * 64 + 32 + j4); }
    vsg_load<PH>(p.vsg, P, C_RV + h * 128, C_RG + h * 128, (const bf16_t*)(ws + WS_STATE + 2 * STATE_BR) + (size_t)((bl * 4 + h) * 64 + c) * 8192, tid);
}
template <int PH>
__device__ __forceinline__ void ret_compute(const RetPre& p, unsigned char* ws, LAS unsigned char* lds, const NormW& nw, int u, int tid) {
    const int bl = u >> 8, h = (u >> 6) & 3, c = u & 63, lane = tid & 63, wave = __builtin_amdgcn_readfirstlane(tid >> 6);
    bf16_t* P = (bf16_t*)(ws + WS_PROJ) + (size_t)(bl * SEQ + c * 64) * PLD;
    LAS bf16_t* QT = (LAS bf16_t*)(lds + OFF_QT); LAS bf16_t* KT = (LAS bf16_t*)(lds + OFF_KT); LAS bf16_t* AM = (LAS bf16_t*)(lds + OFF_AM);
    const int bh = bl * 4 + h;
    const float lg = __logf(1.0f - exp2f(-5.0f - (float)h));
    __syncthreads();
    {
        const int t = tid >> 3, j4 = (tid & 7) * 4;
        const f32x4 cs = p.cs, sn = p.sn;
        const float k1[4] = {bflo(p.k1.x), bfhi(p.k1.x), bflo(p.k1.y), bfhi(p.k1.y)}, k2[4] = {bflo(p.k2.x), bfhi(p.k2.x), bflo(p.k2.y), bfhi(p.k2.y)};
        float ka[4], kb[4];
#pragma unroll
        for (int i = 0; i < 4; ++i) { ka[i] = (k1[i] * cs[i] - k2[i] * sn[i]) * 0.125f; kb[i] = (k1[i] * sn[i] + k2[i] * cs[i]) * 0.125f; }
        if (PH == 3) {
            const float q1[4] = {bflo(p.q1.x), bfhi(p.q1.x), bflo(p.q1.y), bfhi(p.q1.y)}, q2[4] = {bflo(p.q2.x), bfhi(p.q2.x), bflo(p.q2.y), bfhi(p.q2.y)};
            float qa[4], qb[4];
#pragma unroll
            for (int i = 0; i < 4; ++i) { qa[i] = q1[i] * cs[i] - q2[i] * sn[i]; qb[i] = q1[i] * sn[i] + q2[i] * cs[i]; }
            const float gq = __expf(lg * (float)(t + 1));
            u32x2 w;
            w.x = pk2(qa[0], qa[1]); w.y = pk2(qa[2], qa[3]); *(LAS u32x2*)(QT + t * 72 + j4) = w;
            w.x = pk2(qb[0], qb[1]); w.y = pk2(qb[2], qb[3]); *(LAS u32x2*)(QT + t * 72 + 32 + j4) = w;
            w.x = pk2(ka[0], ka[1]); w.y = pk2(ka[2], ka[3]); *(LAS u32x2*)(KT + t * 72 + j4) = w;
            w.x = pk2(kb[0], kb[1]); w.y = pk2(kb[2], kb[3]); *(LAS u32x2*)(KT + t * 72 + 32 + j4) = w;
            w.x = pk2(qa[0] * gq, qa[1] * gq); w.y = pk2(qa[2] * gq, qa[3] * gq); *(LAS u32x2*)(AM + t * 136 + 64 + j4) = w;
            w.x = pk2(qb[0] * gq, qb[1] * gq); w.y = pk2(qb[2] * gq, qb[3] * gq); *(LAS u32x2*)(AM + t * 136 + 96 + j4) = w;
        } else {
            const float gk = __expf(lg * (float)(63 - t));
            u32x2 w;
            w.x = pk2(ka[0] * gk, ka[1] * gk); w.y = pk2(ka[2] * gk, ka[3] * gk); *(LAS u32x2*)(KT + t * 72 + j4) = w;
            w.x = pk2(kb[0] * gk, kb[1] * gk); w.y = pk2(kb[2] * gk, kb[3] * gk); *(LAS u32x2*)(KT + t * 72 + 32 + j4) = w;
        }
    }
    vsg_store<PH>(p.vsg, lds, tid);
    __syncthreads();
    if (PH == 3) {
        tile_mm<4, 4, 2>(wave, lane,
            [&](int m0, int ks) { return frag_kc(QT, 72, m0, ks * 32, lane); },
            [&](int n0, int ks) { return frag_kc(KT, 72, n0, ks * 32, lane); },
            [&](int t, int s0, const f32x4& acc) { float r[4];
#pragma unroll
                for (int j = 0; j < 4; ++j) r[j] = acc[j] * __expf(lg * fabsf((float)(t - s0 - j)));
                u32x2 w; w.x = pk2(r[0], r[1]); w.y = pk2(r[2], r[3]); *(LAS u32x2*)(AM + t * 136 + s0) = w; });
        __syncthreads();
        out128_tail(lds, (bf16_t*)(ws + WS_OUTN + 3 * OUTN_BR) + (size_t)(bl * SEQ + c * 64) * 512, h * 128, nw, p.vsg.g0, p.vsg.g1, tid);
    } else {
        local128_tail(lds, (bf16_t*)(ws + WS_LOCAL + 2 * LOCAL_BR) + (size_t)(bh * 64 + c) * 8192, tid);
        if (tid < 64) ((float*)(ws + WS_DEC + 2 * DEC_BR))[(size_t)(bh * 64 + c) * 64 + tid] = __expf(64.0f * lg);
    }
}

constexpr int OFF_XB = OFF_ST;
struct MambaPre { u32x4 xb[7]; f32x4 cw; u32x4 st[4]; u32x4 z[4]; unsigned short raw; float dtb, alog; };
__device__ __forceinline__ int mamba_gch(int g, int lc) { return lc < 256 ? g * 256 + lc : lc < 320 ? 512 + g * 64 + (lc - 256) : 640 + g * 64 + (lc - 320); }
template <int PH>
__device__ __forceinline__ void mamba_load(MambaPre& p, unsigned char* ws, const float* convw, const float* convb, const float* dtb, const float* alog, int l, int u, int tid) {
    const int bl = u >> 7, g = (u >> 6) & 1, c = u & 63, lane = tid & 63, wave = __builtin_amdgcn_readfirstlane(tid >> 6);
    const bf16_t* PB = (const bf16_t*)(ws + WS_PROJ);
    const bf16_t* P = PB + (size_t)(bl * SEQ + c * 64) * PLD;
    if (tid < 256) { const int hh = g * 4 + wave; p.raw = P[(size_t)lane * PLD + C_DT + hh]; p.dtb = dtb[l * 8 + hh]; p.alog = alog[l * 8 + hh]; }
#pragma unroll
    for (int j = 0; j < 7; ++j) { const int id = tid + 512 * j, r = id / 48, c8 = id % 48, pos = c * 64 + r - 3;
        p.xb[j] = (u32x4){0u, 0u, 0u, 0u};
        if (id < 67 * 48 && pos >= 0) p.xb[j] = *(const u32x4*)(PB + (size_t)(bl * SEQ + pos) * PLD + C_SX + mamba_gch(g, c8 * 8)); }
    if (tid < 480) { const int w = tid / 96, lc = (tid % 96) * 4;
        p.cw = (tid < 384) ? *(const f32x4*)(convw + (size_t)(l * 4 + w) * 768 + mamba_gch(g, lc)) : *(const f32x4*)(convb + l * 768 + mamba_gch(g, (tid - 384) * 4)); }
    if (PH == 3) {
#pragma unroll
        for (int e = 0; e < 4; ++e) p.st[e] = *(const u32x4*)((const bf16_t*)(ws + WS_STATE + 3 * STATE_BR) + (size_t)((bl * 8 + g * 4 + e) * 64 + c) * 4096 + tid * 8);
        const bf16_t* zp = P + (size_t)(tid >> 3) * PLD + C_SZ + g * 256 + (tid & 7) * 32;
#pragma unroll
        for (int j = 0; j < 4; ++j) p.z[j] = *(const u32x4*)(zp + 8 * j);
    }
}
template <int PH>
__device__ __forceinline__ void mamba_compute(const MambaPre& p, unsigned char* ws, LAS unsigned char* lds, const float* ssmd, const float* snorm, int l, int u, int tid) {
    const int bl = u >> 7, g = (u >> 6) & 1, c = u & 63, lane = tid & 63, wave = __builtin_amdgcn_readfirstlane(tid >> 6);
    bf16_t* P = (bf16_t*)(ws + WS_PROJ) + (size_t)(bl * SEQ + c * 64) * PLD;
    LAS float* DT = (LAS float*)(lds + OFF_SEG); LAS float* CH = DT + 256;
    LAS bf16_t* QT = (LAS bf16_t*)(lds + OFF_QT); LAS bf16_t* KT = (LAS bf16_t*)(lds + OFF_KT); LAS bf16_t* AM = (LAS bf16_t*)(lds + OFF_AM);
    LAS bf16_t* V = (LAS bf16_t*)(lds + OFF_V); LAS bf16_t* ST = (LAS bf16_t*)(lds + OFF_ST); LAS bf16_t* XB = (LAS bf16_t*)(lds + OFF_XB);
    LAS float* CW = (LAS float*)(lds + OFF_AM);
    __syncthreads();
    if (tid < 256) {
        const float dt = softplus_f(bf2f(p.raw) + p.dtb);
        float x = -__expf(p.alog) * dt;
#pragma unroll
        for (int off = 1; off < 64; off <<= 1) { const float y = __shfl_up(x, off); if (lane >= off) x += y; }
        DT[wave * 64 + lane] = dt; CH[wave * 64 + lane] = x;
    }
#pragma unroll
    for (int j = 0; j < 7; ++j) { const int id = tid + 512 * j; if (id < 67 * 48) *(LAS u32x4*)(XB + (id / 48) * 384 + (id % 48) * 8) = p.xb[j]; }
    if (tid < 480) *(LAS f32x4*)(CW + tid * 4) = p.cw;
    __syncthreads();
#pragma unroll 2
    for (int j = 0; j < 6; ++j) {
        const int id = tid + 512 * j, t = id / 48, c8 = id % 48;
        float acc[8];
        { const f32x4 b0 = *(const LAS f32x4*)(CW + 1536 + c8 * 8), b1 = *(const LAS f32x4*)(CW + 1536 + c8 * 8 + 4);
#pragma unroll
          for (int i = 0; i < 4; ++i) { acc[i] = b0[i]; acc[4 + i] = b1[i]; } }
#pragma unroll
        for (int w = 0; w < 4; ++w) { const u32x4 xw = *(const LAS u32x4*)(XB + (t + w) * 384 + c8 * 8); float xv[8]; unpack8(xw, xv);
            const f32x4 w0 = *(const LAS f32x4*)(CW + w * 384 + c8 * 8), w1 = *(const LAS f32x4*)(CW + w * 384 + c8 * 8 + 4);
#pragma unroll
            for (int i = 0; i < 4; ++i) { acc[i] += xv[i] * w0[i]; acc[4 + i] += xv[4 + i] * w1[i]; } }
#pragma unroll
        for (int i = 0; i < 8; ++i) acc[i] = siluf_(acc[i]);
        if (c8 < 32) {
            if (PH == 1) { const int e = c8 >> 3; const float wgt = DT[e * 64 + t] * __expf(CH[e * 64 + 63] - CH[e * 64 + t]);
#pragma unroll
                for (int i = 0; i < 8; ++i) acc[i] *= wgt; }
            *(LAS u32x4*)(V + t * LDV + c8 * 8) = pack8(acc);
        } else if (c8 < 40) *(LAS u32x4*)(KT + t * 72 + (c8 - 32) * 8) = pack8(acc);
        else *(LAS u32x4*)(QT + t * 72 + (c8 - 40) * 8) = pack8(acc);
    }
    __syncthreads();
    if (PH == 1) {
        bf16_t* loc = (bf16_t*)(ws + WS_LOCAL + 3 * LOCAL_BR);
        tile_mm<16, 4, 2>(wave, lane,
            [&](int m0, int ks) { return frag_tr(V, LDV, m0, ks * 32, lane); },
            [&](int n0, int ks) { return frag_tr(KT, 72, n0, ks * 32, lane); },
            [&](int hp, int m0, const f32x4& acc) { const int e = hp >> 6, pp = hp & 63; u32x2 w; w.x = pk2_acc(acc[0], acc[1]); w.y = pk2_acc(acc[2], acc[3]); *(u32x2*)(loc + ((size_t)((bl * 8 + g * 4 + e) * 64 + c) * 64 + pp) * 64 + m0) = w; });
        if (tid < 256) ((float*)(ws + WS_DEC + 3 * DEC_BR))[(size_t)((bl * 8 + g * 4 + wave) * 64 + c) * 64 + lane] = __expf(CH[wave * 64 + 63]);
    } else {
        LAS float* GS = (LAS float*)(lds + OFF_CUM);
        tile_mm<4, 4, 2>(wave, lane,
            [&](int m0, int ks) { return frag_kc(QT, 72, m0, ks * 32, lane); },
            [&](int n0, int ks) { return frag_kc(KT, 72, n0, ks * 32, lane); },
            [&](int t, int s0, const f32x4& acc) { *(LAS f32x4*)(GS + t * 68 + s0) = acc; });
        __syncthreads();
        LAS bf16_t* O16 = (LAS bf16_t*)(lds + OFF_O);
#pragma unroll
        for (int e = 0; e < 4; ++e) {
            const int hh = g * 4 + e;
            *(LAS u32x4*)(ST + (tid >> 3) * 72 + (tid & 7) * 8) = p.st[e];
            { const int t = tid >> 3, s8 = (tid & 7) * 8; const float cht = CH[e * 64 + t];
              const f32x4 g0 = *(const LAS f32x4*)(GS + t * 68 + s8), g1 = *(const LAS f32x4*)(GS + t * 68 + s8 + 4);
              const f32x4 h0 = *(const LAS f32x4*)(CH + e * 64 + s8), h1 = *(const LAS f32x4*)(CH + e * 64 + s8 + 4);
              const f32x4 d0 = *(const LAS f32x4*)(DT + e * 64 + s8), d1 = *(const LAS f32x4*)(DT + e * 64 + s8 + 4);
              float pv[8];
#pragma unroll
              for (int i = 0; i < 8; ++i) { const int s = s8 + i; const float gv = (i < 4) ? g0[i & 3] : g1[i & 3], hs = (i < 4) ? h0[i & 3] : h1[i & 3], ds = (i < 4) ? d0[i & 3] : d1[i & 3];
                  pv[i] = (s <= t) ? gv * __expf(cht - hs) * ds : 0.f; }
              *(LAS u32x4*)(AM + t * 136 + s8) = pack8(pv);
              const u32x4 cw = *(const LAS u32x4*)(QT + t * 72 + s8); float cv[8]; unpack8(cw, cv); const float ec = __expf(cht);
#pragma unroll
              for (int i = 0; i < 8; ++i) cv[i] *= ec;
              *(LAS u32x4*)(AM + t * 136 + 64 + s8) = pack8(cv); }
            __syncthreads();
            const float Dh = ssmd[l * 8 + hh];
            tile_mm<4, 4, 4>(wave, lane,
                [&](int m0, int ks) { return frag_kc(AM, 136, m0, ks * 32, lane); },
                [&](int n0, int ks) { return ks < 2 ? frag_tr(V + e * 64, LDV, n0, ks * 32, lane) : frag_kc(ST, 72, n0, (ks - 2) * 32, lane); },
                [&](int t, int p0, const f32x4& acc) {
                    const u32x2 xw = *(const LAS u32x2*)(V + t * LDV + e * 64 + p0);
                    u32x2 w; w.x = pk2(acc[0] + Dh * bflo(xw.x), acc[1] + Dh * bfhi(xw.x)); w.y = pk2(acc[2] + Dh * bflo(xw.y), acc[3] + Dh * bfhi(xw.y));
                    *(LAS u32x2*)(O16 + t * LDV + e * 64 + p0) = w; });
            __syncthreads();
        }
        const int t = tid >> 3, sub = tid & 7;
        float y[32]; float ss = 0.f;
#pragma unroll
        for (int j = 0; j < 4; ++j) { const u32x4 w = *(const LAS u32x4*)(O16 + t * LDV + sub * 32 + 8 * j); float f[8], zf[8]; unpack8(w, f); unpack8(p.z[j], zf);
#pragma unroll
            for (int i = 0; i < 8; ++i) { const float yy = f[i] * siluf_(zf[i]); y[8 * j + i] = yy; ss += yy * yy; } }
        ss += __shfl_xor(ss, 1); ss += __shfl_xor(ss, 2); ss += __shfl_xor(ss, 4);
        const float r = 1.0f / sqrtf(ss * (1.0f / 256.0f) + EPS);
        const float* nwp = snorm + l * 512 + g * 256 + sub * 32;
        bf16_t* op = (bf16_t*)(ws + WS_OUTN + 2 * OUTN_BR) + (size_t)(bl * SEQ + c * 64 + t) * 512 + g * 256 + sub * 32;
#pragma unroll
        for (int j = 0; j < 4; ++j) { const f32x4 w0 = *(const f32x4*)(nwp + 8 * j), w1 = *(const f32x4*)(nwp + 8 * j + 4); float res[8];
#pragma unroll
            for (int i = 0; i < 4; ++i) { res[i] = y[8 * j + i] * r * w0[i]; res[4 + i] = y[8 * j + 4 + i] * r * w1[i]; }
            *(u32x4*)(op + 8 * j) = pack8(res); }
    }
}

template <int PH>
__device__ __forceinline__ void phase_mixer(const KA a, LAS unsigned char* lds, int l, int tid) {
    const int G = gridDim.x, bid = blockIdx.x;
    unsigned char* ws = a.ws();
    for (int rep_ = 0; rep_ < ((PH == 3 && DUP_PHASE == 40) ? 2 : 1); ++rep_)
    {
        const float* convw = a.in(I_CONVW); const float* convb = a.in(I_CONVB); const float* dtb = a.in(I_DTB); const float* alog = a.in(I_ALOG); const float* ssmd = a.in(I_SSMD); const float* snorm = a.in(I_SNORM);
        MambaPre pre; int u = bid; if (u < 512) mamba_load<PH>(pre, ws, convw, convb, dtb, alog, l, u, tid);
        for (; u < 512; u += G) { const MambaPre cur = pre; if (u + G < 512) mamba_load<PH>(pre, ws, convw, convb, dtb, alog, l, u + G, tid); mamba_compute<PH>(cur, ws, lds, ssmd, snorm, l, u, tid); }
    }
    for (int rep_ = 0; rep_ < ((PH == 3 && DUP_PHASE == 41) ? 2 : 1); ++rep_)
    {
        const float* wlr = a.in(I_WLR); const float* blr = a.in(I_BLR); NormW nw;
        if (PH == 3) { const float* np = a.in(I_GNORM) + l * 128 + (tid & 7) * 16;
#pragma unroll
            for (int j = 0; j < 4; ++j) nw.w[j] = *(const f32x4*)(np + 4 * j); }
        GlPre pre; int u = bid; if (u < 1024) gl_load<0, PH>(pre, ws, wlr, blr, l, u, tid);
        for (; u < 1024; u += G) { const GlPre cur = pre; if (u + G < 1024) gl_load<0, PH>(pre, ws, wlr, blr, l, u + G, tid); gl_compute<0, PH>(cur, ws, lds, nw, l, u, tid); }
    }
    for (int rep_ = 0; rep_ < ((PH == 3 && DUP_PHASE == 42) ? 2 : 1); ++rep_)
    {
        const float* hlb = a.in(I_HLB); NormW nw;
        if (PH == 3) { const float* np = a.in(I_HNORM) + l * 128 + (tid & 7) * 16;
#pragma unroll
            for (int j = 0; j < 4; ++j) nw.w[j] = *(const f32x4*)(np + 4 * j); }
        GlPre pre; int u = bid; if (u < 1024) gl_load<1, PH>(pre, ws, hlb, hlb, l, u, tid);
        for (; u < 1024; u += G) { const GlPre cur = pre; if (u + G < 1024) gl_load<1, PH>(pre, ws, hlb, hlb, l, u + G, tid); gl_compute<1, PH>(cur, ws, lds, nw, l, u, tid); }
    }
    for (int rep_ = 0; rep_ < ((PH == 3 && DUP_PHASE == 43) ? 2 : 1); ++rep_)
    {
        NormW nw;
        if (PH == 3) { const float* np = a.in(I_RNORM) + l * 128 + (tid & 7) * 16;
#pragma unroll
            for (int j = 0; j < 4; ++j) nw.w[j] = *(const f32x4*)(np + 4 * j); }
        RetPre pre; int u = bid; if (u < 1024) ret_load<PH>(pre, ws, u, tid);
        for (; u < 1024; u += G) { const RetPre cur = pre; if (u + G < 1024) ret_load<PH>(pre, ws, u + G, tid); ret_compute<PH>(cur, ws, lds, nw, u, tid); }
    }
    __syncthreads();
}

__device__ __forceinline__ void phase_scan(const KA a, int tid) {
    const int nthr = gridDim.x * 512;
    for (int gt = blockIdx.x * 512 + tid; gt < 4 * 32768; gt += nthr) {
        const int br = gt >> 15, r = gt & 32767;
        const int E = (br == 3) ? 4096 : 8192;
        const int per = E / 4;
        const int bh = r / per, e4 = r % per, k0 = (e4 * 4) & 63;
        const bf16_t* loc = (const bf16_t*)(a.ws() + WS_LOCAL + br * LOCAL_BR) + (size_t)bh * 64 * E + e4 * 4;
        const float* dec = (const float*)(a.ws() + WS_DEC + br * DEC_BR) + (size_t)bh * 64 * 64 + k0;
        bf16_t* st = (bf16_t*)(a.ws() + WS_STATE + br * STATE_BR) + (size_t)bh * 64 * E + e4 * 4;
        f32x4 S = (f32x4){0.f, 0.f, 0.f, 0.f};
        for (int c0 = 0; c0 < 64; c0 += 8) {
            u32x2 L[8]; f32x4 Dv[8];
#pragma unroll
            for (int i = 0; i < 8; ++i) { L[i] = *(const u32x2*)(loc + (size_t)(c0 + i) * E); Dv[i] = *(const f32x4*)(dec + (c0 + i) * 64); }
#pragma unroll
            for (int i = 0; i < 8; ++i) { u32x2 w; w.x = pk2(S.x, S.y); w.y = pk2(S.z, S.w); *(u32x2*)(st + (size_t)(c0 + i) * E) = w;
                S = Dv[i] * S + (f32x4){bflo(L[i].x), bfhi(L[i].x), bflo(L[i].y), bfhi(L[i].y)}; }
        }
    }
}

constexpr int NPH_PER = 7, NPHASE = 1 + DEPTH * 2 * NPH_PER + 1;
__global__ void __launch_bounds__(512, 2) fwd(Args ka) {
    extern __shared__ __attribute__((aligned(16))) unsigned char lds_raw[];
    LAS unsigned char* lds = (LAS unsigned char*)lds_raw;
    const int tid = threadIdx.x, lane = tid & 63, wave = __builtin_amdgcn_readfirstlane(tid >> 6);
    const int G = gridDim.x;
    const int gw = blockIdx.x * 8 + wave, ngw = G * 8;
    volatile LAS unsigned* MISC = (volatile LAS unsigned*)(lds + MISC_OFF);
    if (tid < 16) MISC[tid] = 0u;
    if (tid < 18) ((volatile LAS unsigned long long*)(lds + MISC_OFF + 64))[tid] = (unsigned long long)ka.in[tid];
    if (tid == 18) ((volatile LAS unsigned long long*)(lds + MISC_OFF + 64))[18] = (unsigned long long)ka.out;
    if (tid == 19) ((volatile LAS unsigned long long*)(lds + MISC_OFF + 64))[19] = (unsigned long long)ka.ws;
    __syncthreads();
    const KA a{lds};
    const int ph_lo = ka.ph_lo, ph_hi = ka.ph_hi, single = ka.single;
    XcdBarrier bar; bar.bar = (unsigned*)(ka.ws + WS_CTL); bar.x = 0; bar.st = MISC + 8;
    if (single) bar = xcd_barrier_post((unsigned*)(ka.ws + WS_CTL), MISC + 8);
#define IN(p) (ph_lo <= (p) && (p) < ph_hi)
#define GRID_BAR() do { if (single) xcd_barrier(bar); } while (0)
#define OPQ_TID() ({ int t__ = threadIdx.x; asm volatile("" : "+v"(t__)); t__; })
    if (IN(0)) {
        const int t_ = OPQ_TID(), lane_ = t_ & 63, wave_ = __builtin_amdgcn_readfirstlane(t_ >> 6), gw_ = blockIdx.x * 8 + wave_;
        phase_weights(a, lds, 0, gw_, ngw, wave_, lane_); phase_rope(a, blockIdx.x * 512 + t_, G * 512);
        phase_x_in(a.in(I_X), (bf16_t*)(a.ws() + WS_X16), (float*)(a.ws() + WS_RSQ), (float*)(a.ws() + WS_RINV), BATCH * SEQ, gw_, ngw, lane_);
        GRID_BAR();
    }
    for (int l = 0; l < DEPTH; ++l) {
        for (int hf = 0; hf < 2; ++hf) {
            const int pb = 1 + (l * 2 + hf) * NPH_PER;
            const size_t rowoff = (size_t)hf * MH;
            bf16_t* X16 = (bf16_t*)(a.ws() + WS_X16) + rowoff * D;
            float* RSQ = (float*)(a.ws() + WS_RSQ) + rowoff * 16;
            bf16_t* HB = (bf16_t*)(a.ws() + WS_HB);
            bf16_t* PROJ = (bf16_t*)(a.ws() + WS_PROJ);
            if (EN_N && IN(pb + 0) && hf == 0 && l > 0) {
                const int t_ = OPQ_TID(), lane_ = t_ & 63, wave_ = __builtin_amdgcn_readfirstlane(t_ >> 6), gw_ = blockIdx.x * 8 + wave_;
                phase_weights(a, lds, l, gw_, ngw, wave_, lane_);
                GRID_BAR();
            }
            if (EN_A && IN(pb + 1)) {
                pg8::Gemm g{X16, (const bf16_t*)(a.ws() + WS_WIN), MH, NP, D, D, D, 0, 0, 0}; pg8::StaticOrder S; S.init(MH, NP, G, (int)blockIdx.x);
                pg8::EpiProj E{PROJ, a.ws() + WS_GATES, (const float*)(a.ws() + WS_RINV) + rowoff};
                pg8::gemm_phase<pg8::EpiProj, true>(lds, g, S, E, OPQ_TID());
                GRID_BAR();
            }
            if (EN_B1 && IN(pb + 2)) { phase_mixer<1>(a, lds, l, OPQ_TID()); GRID_BAR(); }
            if (EN_B2 && IN(pb + 3)) { const int t_ = OPQ_TID(); phase_scan(a, t_);
                { const size_t oro = (size_t)(1 - hf) * MH; phase_rinv((const float*)(a.ws() + WS_RSQ) + oro * 16, (float*)(a.ws() + WS_RINV) + oro, MH, blockIdx.x * 512 + t_, G * 512); }
                GRID_BAR(); }
            if (EN_B3 && IN(pb + 4)) { for (int rep = 0; rep < (DUP_PHASE == 4 ? 2 : 1); ++rep) phase_mixer<3>(a, lds, l, OPQ_TID()); GRID_BAR(); }
            if (EN_C && IN(pb + 5)) {
                pg8::Gemm g{(const bf16_t*)(a.ws() + WS_OUTN), (const bf16_t*)(a.ws() + WS_WUP), MH, D, 2048, 512, 512, 8, OUTN_BR, (size_t)1024 * 512 * 2}; pg8::StaticOrder S; S.init(MH, D, G, (int)blockIdx.x);
                pg8::EpiUp E{a.ws() + WS_GATES, HB};
                pg8::gemm_phase<pg8::EpiUp, false>(lds, g, S, E, OPQ_TID());
                GRID_BAR();
            }
            if (EN_D && IN(pb + 6)) {
                pg8::Gemm g{HB, (const bf16_t*)(a.ws() + WS_WOUT), MH, D, D, D, D, 0, 0, 0}; pg8::StaticOrder S; S.init(MH, D, G, (int)blockIdx.x);
                pg8::EpiOut E{X16, RSQ};
                pg8::gemm_phase<pg8::EpiOut, false>(lds, g, S, E, OPQ_TID());
                GRID_BAR();
            }
        }
    }
    if (IN(NPHASE - 1)) phase_final((const bf16_t*)(a.ws() + WS_X16), a.out(), a.in(I_FNORM), BATCH * SEQ, gw, ngw, lane);
#undef IN
#undef GRID_BAR
}

extern "C" void kernel_launch(void* const* d_in, const int* in_sizes, int n_in, void* d_out, int out_size, void* d_ws, size_t ws_size, hipStream_t stream) {
    static int grid = 0;
    if (grid == 0) {
        if (n_in != 18 || in_sizes[0] != BATCH * SEQ * D || out_size != BATCH * SEQ * D || ws_size < WS_END) {
            fprintf(stderr, "kernel_launch: unexpected shapes (n_in %d, in0 %d, out %d, ws %zu, need %zu)\n", n_in, n_in > 0 ? in_sizes[0] : -1, out_size, ws_size, (size_t)WS_END); grid = -1; return; }
        int dev = 0, cus = 0, per_cu = 0;
        if (hipGetDevice(&dev) != hipSuccess || hipDeviceGetAttribute(&cus, hipDeviceAttributeMultiprocessorCount, dev) != hipSuccess) { grid = -1; return; }
        if (hipFuncSetAttribute((const void*)fwd, hipFuncAttributeMaxDynamicSharedMemorySize, LDS_BYTES) != hipSuccess) { fprintf(stderr, "kernel_launch: hipFuncSetAttribute failed\n"); grid = -1; return; }
        if (hipOccupancyMaxActiveBlocksPerMultiprocessor(&per_cu, (const void*)fwd, 512, LDS_BYTES) != hipSuccess || per_cu < 1)
            fprintf(stderr, "kernel_launch: occupancy query reports %d workgroups per CU\n", per_cu);
        (void)hipGetLastError();
        grid = cus;
    }
    if (grid < 0) return;
    (void)hipMemsetAsync((char*)d_ws + WS_CTL, 0, CTL_BYTES, stream);
    Args a{};
    for (int i = 0; i < 18; ++i) a.in[i] = (const float*)d_in[i];
    a.out = (float*)d_out; a.ws = (unsigned char*)d_ws; a.pad = 0;
#if MK_PER_PHASE_LAUNCH
    for (int p = 0; p < NPHASE; ++p) { a.ph_lo = p; a.ph_hi = p + 1; a.single = 0; hipLaunchKernelGGL(fwd, dim3(grid), dim3(512), LDS_BYTES, stream, a); }
#else
    a.ph_lo = 0; a.ph_hi = NPHASE; a.single = 1;
    hipLaunchKernelGGL(fwd, dim3(grid), dim3(512), LDS_BYTES, stream, a);
#endif
}
```

```cpp
#include <hip/hip_runtime.h>
#ifndef EN_N
#define EN_N 1
#define EN_A 1
#define EN_B1 1
#define EN_B2 1
#define EN_B3 1
#define EN_C 1
#define EN_D 1
#endif
#include <cstdio>
#include <cstdint>

#ifndef DUP_PHASE
#define DUP_PHASE -1
#endif
#ifndef D_A_NOBAR
#define D_A_NOBAR 1
#endif
#ifndef PK8_BIAS
#define PK8_BIAS 0.0f
#endif
#ifndef SKEW_TICKS
#define SKEW_TICKS 200
#endif
#ifndef SKEW_GROUPS
#define SKEW_GROUPS 1
#endif
#ifndef MK_PER_PHASE_LAUNCH
#define MK_PER_PHASE_LAUNCH 0
#endif

#define LAS __attribute__((address_space(3)))
#define GAS __attribute__((address_space(1)))
typedef unsigned short bf16_t;
typedef short bf16x8 __attribute__((ext_vector_type(8)));
typedef float f32x4 __attribute__((ext_vector_type(4)));
typedef unsigned u32x4 __attribute__((ext_vector_type(4)));
typedef unsigned u32x2 __attribute__((ext_vector_type(2)));
typedef int i32x4 __attribute__((ext_vector_type(4)));

constexpr int D = 1024, BATCH = 8, SEQ = 4096, DEPTH = 4, NIN = 10008, NP = 10240, PLD = 6144;
constexpr int HBATCH = 4, MH = HBATCH * SEQ;
constexpr float EPS = 1e-6f;
constexpr int C_GQ = 0, C_GK = 256, C_GV = 512, C_GG = 1024, C_HQ = 1536, C_HF = 1792, C_HI = 2048, C_HG = 2560, C_SZ = 3072, C_SX = 3584,
              C_RQ = 4352, C_RK = 4608, C_RV = 4864, C_RG = 5376, C_LR = 5888, C_DT = 5904, C_MG = 6144;
__host__ __device__ __forceinline__ int origcol(int c) {
    if (c < 1024) return c;
    if (c < 4352) return c + 16;
    if (c < 5888) return c + 24;
    if (c < 5904) return c - 5888 + 1024;
    if (c < 5912) return c - 5904 + 4368;
    if (c < 6144) return -1;
    return c - 232;
}
__host__ __device__ __forceinline__ size_t pofs(int t, int col) { return (size_t)(((col >> 6) * 64 + t) * 64 + (col & 63)); }
enum { I_X = 0, I_NORMW, I_WIN, I_WLR, I_BLR, I_GNORM, I_HLB, I_HNORM, I_CONVW, I_CONVB, I_DTB, I_ALOG, I_SSMD, I_SNORM, I_RNORM, I_WUP, I_WOUT, I_FNORM };

constexpr int N8 = 8192;
constexpr size_t WS_CTL = 0, WS_CMAX = 16384, CTL_BYTES = 16384 + 4 * N8 * 4;
constexpr size_t WS_ROPE = 262144;
constexpr size_t WS_WIN = WS_ROPE + 2 * 4096 * 32 * 4;
constexpr size_t WS_WUP = WS_WIN + (size_t)NP * 1024 * 2;
constexpr size_t WS_WOUT = WS_WUP + (size_t)4 * 1024 * 512 * 2;
constexpr size_t WS_HB = WS_WOUT + (size_t)1024 * 1024 * 2;
constexpr size_t WS_PROJ = WS_HB + (size_t)MH * 1024 * 2;
constexpr size_t LOCAL_BR = (size_t)16 * 64 * 128 * 64 * 4;
constexpr size_t WS_GATES = WS_PROJ + (size_t)MH * PLD * 2;
constexpr size_t WS_LOCAL = WS_GATES + (size_t)MH * 4096;
constexpr size_t STATE_BR = LOCAL_BR / 2;
constexpr size_t WS_STATE = WS_LOCAL + 4 * LOCAL_BR;
constexpr size_t DEC_BR = (size_t)32 * 64 * 64 * 4;
constexpr size_t WS_DEC = WS_STATE + 4 * STATE_BR;
constexpr size_t WS_X16 = WS_DEC + 4 * DEC_BR;
constexpr size_t WS_RSQ = WS_X16 + (size_t)BATCH * SEQ * 1024 * 2;
constexpr size_t WS_RINV = WS_RSQ + (size_t)BATCH * SEQ * 16 * 4;
constexpr size_t WS_X8 = WS_RINV + (size_t)BATCH * SEQ * 4;
constexpr size_t WS_SXI = WS_X8 + (size_t)BATCH * SEQ * 1024;
constexpr size_t WS_W8 = WS_SXI + (size_t)BATCH * SEQ * 4;
constexpr size_t WS_END = WS_W8 + (size_t)N8 * 1024;
static_assert(WS_END <= (size_t)4 * 4 * 1024 * 10008 * 4 && CTL_BYTES <= WS_ROPE, "workspace");
__host__ __device__ __forceinline__ int sel8(int p) { return p < 6 ? p : p < 10 ? p + 2 : p + 7; }
__host__ __device__ __forceinline__ int sel8inv(int t) { return t < 6 ? t : t < 12 ? t - 2 : t - 7; }
__host__ __device__ __forceinline__ bool is_sel8(int t) { return t <= 5 || (t >= 8 && t <= 11) || (t >= 17 && t <= 22); }
__host__ __device__ __forceinline__ int keep16(int p) { return p < 2 ? p + 6 : p < 7 ? p + 10 : 23; }
constexpr size_t WS_OUTN = WS_LOCAL;
constexpr size_t OUTN_BR = (size_t)MH * 512 * 2;

constexpr int LDS_BYTES = 147456;
constexpr int MISC_OFF = LDS_BYTES - 256;
constexpr int OFF_CUM = 0, OFF_SEG = 17408, OFF_QT = 19456, OFF_KT = 28672, OFF_AM = 37888, OFF_V = 55296, OFF_ST = 89088, OFF_O = 107520;
constexpr int LDV = 264;
constexpr int OFF_OML = 141312;
constexpr int OFF_LUT = 141568;

namespace pg8 {
constexpr int BM = 256, BK = 64, HALF = 128, HTB = HALF * BK * 2, STAGE_BYTES = 8 * HTB, NXCD = 8, WGM = 8;
__host__ __device__ __forceinline__ int lds_byte(int r, int c) { const int st = (r >> 4) * 2 + (c >> 5), rr = r & 15, cc = c & 31, ob = rr * 64 + cc * 2; return st * 1024 + (ob ^ (((ob >> 9) & 1) << 5)); }
__host__ __device__ __forceinline__ void stage_rc(int b, int& R, int& C) { const int st = b / 1024, sb = b % 1024, swz = sb ^ (((sb >> 9) & 1) << 5); R = (st >> 1) * 16 + swz / 64; C = (st & 1) * 32 + (swz % 64) / 2; }
__host__ __device__ __forceinline__ int perm32(int rho) { const int n = rho >> 4, i = rho & 15; return 8 * (i >> 2) + 4 * n + (i & 3); }
struct Unit { int pm, pn; };
struct Gemm { const GAS bf16_t* A; const GAS bf16_t* Bt; int M, N, K, lda, ldb; int kseg; size_t segA, segB; };
struct StaticOrder {
    int nM, nN, nwg, G, c, keep;
    __host__ __device__ void init(int M, int N, int G_, int c_) { nM = M / BM; nN = N / BM; nwg = nM * nN; G = G_; c = c_; keep = 0; }
    __host__ __device__ bool next(int i, Unit& u) const {
        const long L = (long)i * G + c; if (L >= nwg) return false;
        int wgid = (int)L; { const int q = nwg / NXCD, r = nwg % NXCD, xcd = wgid % NXCD, off = wgid / NXCD; wgid = (xcd < r ? xcd * (q + 1) : r * (q + 1) + (xcd - r) * q) + off; }
        const int nig = WGM * nN, gid = wgid / nig, fm = gid * WGM, gsz = (nM - fm) < WGM ? (nM - fm) : WGM;
        u.pm = fm + ((wgid % nig) % gsz); u.pn = (wgid % nig) / gsz; if (keep) u.pn = keep16(u.pn); return true;
    }
};
__device__ __forceinline__ unsigned cvt_pk_bf16(float lo, float hi) { unsigned r; asm volatile("v_cvt_pk_bf16_f32 %0, %1, %2" : "=v"(r) : "v"(lo), "v"(hi)); return r; }

struct EpiProj {
    static constexpr bool PERM = true, SEG = false, I8 = false;
    GAS bf16_t* O; const GAS float* Rinv;
    __device__ __forceinline__ void operator()(const f32x4 (&acc)[2][2][4][2], const Unit& u, int wr, int wc, int fr, int fq) const {
        const int row0 = u.pm * BM + wr * 64 + fr, col0 = u.pn * BM + wc * 32 + 8 * fq;
        float rs[2][4];
#pragma unroll
        for (int ai = 0; ai < 2; ++ai)
#pragma unroll
            for (int m = 0; m < 4; ++m) rs[ai][m] = Rinv[row0 + ai * HALF + m * 16];
#pragma unroll
        for (int ai = 0; ai < 2; ++ai)
#pragma unroll
            for (int m = 0; m < 4; ++m) { const int rr = row0 + ai * HALF + m * 16; GAS bf16_t* rowp = O + (size_t)(rr >> 6) * (PLD * 64) + pofs(rr & 63, col0);
#pragma unroll
                for (int bj = 0; bj < 2; ++bj) { const f32x4 v0 = acc[ai][bj][m][0] * rs[ai][m], v1 = acc[ai][bj][m][1] * rs[ai][m];
                    u32x4 w; w.x = cvt_pk_bf16(v0[0], v0[1]); w.y = cvt_pk_bf16(v0[2], v0[3]); w.z = cvt_pk_bf16(v1[0], v1[1]); w.w = cvt_pk_bf16(v1[2], v1[3]);
                    *(GAS u32x4*)(rowp + bj * (2 * 4096)) = w; } }
    }
};
struct EpiI8 {
    static constexpr bool PERM = true, SEG = false, I8 = true;
    GAS unsigned char* Gt; GAS bf16_t* O; const GAS float* Sx; const GAS unsigned* Cmax; const LAS unsigned char* lut;
    __device__ __forceinline__ void operator()(const f32x4 (&acc)[2][2][4][2], const Unit& u, int wr, int wc, int fr, int fq) const {
        const int row0 = u.pm * BM + wr * 64 + fr, col0 = u.pn * BM + wc * 32 + 8 * fq;
        const bool gate = u.pn < 16;
        float rs[2][4], cs[2][8];
#pragma unroll
        for (int ai = 0; ai < 2; ++ai)
#pragma unroll
            for (int m = 0; m < 4; ++m) rs[ai][m] = Sx[row0 + ai * HALF + m * 16];
#pragma unroll
        for (int bj = 0; bj < 2; ++bj) { const u32x4 c0 = *(const GAS u32x4*)(Cmax + col0 + bj * HALF), c1 = *(const GAS u32x4*)(Cmax + col0 + bj * HALF + 4);
#pragma unroll
            for (int j = 0; j < 4; ++j) { const unsigned u0 = c0[j], u1 = c1[j]; cs[bj][j] = __builtin_bit_cast(float, u0) * (1.0f / 127.0f); cs[bj][4 + j] = __builtin_bit_cast(float, u1) * (1.0f / 127.0f); } }
        GAS unsigned char* gt = Gt + ((size_t)(u.pm * 16 + u.pn) * 65536) + ((wr * 4 + wc) * 64 + fq * 16 + fr) * 16;
        const int colD = sel8(u.pn - 16) * BM + wc * 32 + 8 * fq;
#pragma unroll
        for (int ai = 0; ai < 2; ++ai)
#pragma unroll
            for (int m = 0; m < 4; ++m) { const int rr = row0 + ai * HALF + m * 16; GAS bf16_t* rowp = O + (size_t)(rr >> 6) * (PLD * 64) + pofs(rr & 63, colD); u32x4 w16;
#pragma unroll
                for (int bj = 0; bj < 2; ++bj) { float z[8];
#pragma unroll
                    for (int j = 0; j < 4; ++j) { const float a0 = acc[ai][bj][m][0][j], a1 = acc[ai][bj][m][1][j];
                        z[j] = (float)__builtin_bit_cast(int, a0) * (rs[ai][m] * cs[bj][j]); z[4 + j] = (float)__builtin_bit_cast(int, a1) * (rs[ai][m] * cs[bj][4 + j]); }
                    if (gate) { u32x2 w8; unsigned qv[8];
#pragma unroll
                        for (int j = 0; j < 8; ++j) { const unsigned ix = min((unsigned)fmaf(z[j], 256.0f, 2048.5f), 4095u); qv[j] = (unsigned)lut[ix]; }
                        w8.x = qv[0] | (qv[1] << 8) | (qv[2] << 16) | (qv[3] << 24); w8.y = qv[4] | (qv[5] << 8) | (qv[6] << 16) | (qv[7] << 24);
                        if (bj == 0) { w16.x = w8.x; w16.y = w8.y; } else { w16.z = w8.x; w16.w = w8.y; *(GAS u32x4*)(gt + (size_t)((ai * 4 + m) * 8192)) = w16; } }
                    else { u32x4 w; w.x = cvt_pk_bf16(z[0], z[1]); w.y = cvt_pk_bf16(z[2], z[3]); w.z = cvt_pk_bf16(z[4], z[5]); w.w = cvt_pk_bf16(z[6], z[7]);
                        *(GAS u32x4*)(rowp + bj * (2 * 4096)) = w; } } }
    }
};
struct EpiUp {
    static constexpr bool PERM = true, SEG = true, I8 = false; static constexpr int KSEG = 8;
    const GAS unsigned char* Gt; GAS bf16_t* Mg;
    __device__ __forceinline__ void mid(f32x4 (&acc)[2][2][4][2], const Unit& u, int seg, int wr, int wc, int fr, int fq) const {
        const GAS unsigned char* gpv = Gt + ((size_t)(u.pm * 16 + (seg - 1) * 4 + u.pn) * 65536) + ((wr * 4 + wc) * 64 + fq * 16 + fr) * 16;
#pragma unroll
        for (int ai = 0; ai < 2; ++ai)
#pragma unroll
            for (int mp = 0; mp < 2; ++mp) {
                u32x2 gp[2][2], gc[2][2];
#pragma unroll
                for (int mm = 0; mm < 2; ++mm) { const GAS unsigned char* q = gpv + (size_t)((ai * 4 + mp * 2 + mm) * 8192); const u32x4 p4 = *(const GAS u32x4*)q, c4 = *(const GAS u32x4*)(q + 4 * 65536);
                    gp[mm][0] = (u32x2){p4.x, p4.y}; gp[mm][1] = (u32x2){p4.z, p4.w}; gc[mm][0] = (u32x2){c4.x, c4.y}; gc[mm][1] = (u32x2){c4.z, c4.w}; }
#pragma unroll
                for (int mm = 0; mm < 2; ++mm)
#pragma unroll
                    for (int bj = 0; bj < 2; ++bj) { const int m = mp * 2 + mm;
#pragma unroll
                        for (int e = 0; e < 8; ++e) {
                            const float pv = (float)((gp[mm][bj][e >> 2] >> (8 * (e & 3))) & 0xffu), cv = (float)((gc[mm][bj][e >> 2] >> (8 * (e & 3))) & 0xffu);
                            acc[ai][bj][m][e >> 2][e & 3] *= pv * __builtin_amdgcn_rcpf(cv); } }
                asm volatile("" ::: "memory");
            }
    }
    __device__ __forceinline__ void operator()(const f32x4 (&acc)[2][2][4][2], const Unit& u, int wr, int wc, int fr, int fq) const {
        const int row0 = u.pm * BM + wr * 64 + fr, col0 = u.pn * BM + wc * 32 + 8 * fq;
        const GAS unsigned char* gpv = Gt + ((size_t)(u.pm * 16 + 3 * 4 + u.pn) * 65536) + ((wr * 4 + wc) * 64 + fq * 16 + fr) * 16;
        u32x2 gin[2][4][2];
#pragma unroll
        for (int ai = 0; ai < 2; ++ai)
#pragma unroll
            for (int m = 0; m < 4; ++m) { const u32x4 g4 = *(const GAS u32x4*)(gpv + (size_t)((ai * 4 + m) * 8192)); gin[ai][m][0] = (u32x2){g4.x, g4.y}; gin[ai][m][1] = (u32x2){g4.z, g4.w}; }
#pragma unroll
        for (int ai = 0; ai < 2; ++ai)
#pragma unroll
            for (int m = 0; m < 4; ++m) { const size_t r = (size_t)(row0 + ai * HALF + m * 16);
#pragma unroll
                for (int bj = 0; bj < 2; ++bj) { const int c = col0 + bj * HALF;
                    const u32x2 g = gin[ai][m][bj];
                    float res[8];
#pragma unroll
                    for (int e = 0; e < 8; ++e) res[e] = acc[ai][bj][m][e >> 2][e & 3] * ((float)((g[e >> 2] >> (8 * (e & 3))) & 0xffu) * (1.0f / 255.0f));
                    u32x4 w; w.x = cvt_pk_bf16(res[0], res[1]); w.y = cvt_pk_bf16(res[2], res[3]); w.z = cvt_pk_bf16(res[4], res[5]); w.w = cvt_pk_bf16(res[6], res[7]);
                    *(GAS u32x4*)(Mg + r * 1024 + c) = w; } }
    }
};
struct EpiOut {
    static constexpr bool PERM = true, SEG = false, I8 = false;
    GAS bf16_t* X; GAS float* Rsq;
    __device__ __forceinline__ void operator()(const f32x4 (&acc)[2][2][4][2], const Unit& u, int wr, int wc, int fr, int fq) const {
        const int row0 = u.pm * BM + wr * 64 + fr, col0 = u.pn * BM + wc * 32 + 8 * fq;
#pragma unroll
        for (int ai = 0; ai < 2; ++ai) {
            u32x4 xin[1][4][2];
#pragma unroll
            for (int m = 0; m < 4; ++m)
#pragma unroll
                for (int bj = 0; bj < 2; ++bj) xin[0][m][bj] = *(const GAS u32x4*)(X + (size_t)(row0 + ai * HALF + m * 16) * 1024 + col0 + bj * HALF);
#pragma unroll
            for (int m = 0; m < 4; ++m) { const size_t r = (size_t)(row0 + ai * HALF + m * 16); float ss = 0.f;
#pragma unroll
                for (int bj = 0; bj < 2; ++bj) { GAS bf16_t* xp = X + r * 1024 + col0 + bj * HALF;
                    const u32x4 xo = xin[0][m][bj]; float res[8];
#pragma unroll
                    for (int q = 0; q < 4; ++q) {
                        const float a0 = (q < 2) ? acc[ai][bj][m][0][2 * q] : acc[ai][bj][m][1][2 * q - 4], a1 = (q < 2) ? acc[ai][bj][m][0][2 * q + 1] : acc[ai][bj][m][1][2 * q - 3];
                        res[2 * q] = __builtin_bit_cast(float, xo[q] << 16) + a0; res[2 * q + 1] = __builtin_bit_cast(float, xo[q] & 0xffff0000u) + a1;
                        ss += res[2 * q] * res[2 * q] + res[2 * q + 1] * res[2 * q + 1]; }
                    u32x4 w; w.x = cvt_pk_bf16(res[0], res[1]); w.y = cvt_pk_bf16(res[2], res[3]); w.z = cvt_pk_bf16(res[4], res[5]); w.w = cvt_pk_bf16(res[6], res[7]);
                    *(GAS u32x4*)xp = w; }
                ss += __shfl_xor(ss, 16); ss += __shfl_xor(ss, 32);
                if (fq == 0) Rsq[r * 16 + u.pn * 4 + wc] = ss; }
        }
    }
};

template <class Epi, bool ALIGN_EPI>
__device__ __forceinline__ void gemm_phase(LAS unsigned char* lds, const Gemm g, const StaticOrder& S, const Epi& E, const int tid) {
    const int wid = __builtin_amdgcn_readfirstlane(tid >> 6), lane = tid & 63, wr = wid >> 2, wc = wid & 3, fr = lane & 15, fq = lane >> 4;
    const int K = g.K, nt = K / BK;
    unsigned voffA[2], voffB[2];
#pragma unroll
    for (int i = 0; i < 2; ++i) { int R, C; stage_rc(tid * 16 + i * 8192, R, C); const int Rb = Epi::PERM ? ((R & ~31) + perm32(R & 31)) : R;
        voffA[i] = (unsigned)(R * g.lda + C) * 2u; voffB[i] = (unsigned)(Rb * g.ldb + C) * 2u; }
    const size_t kstep = (size_t)(BK * 2);
    const size_t hstepA = (size_t)HALF * g.lda * 2, hstepB = (size_t)HALF * g.ldb * 2;
    const size_t tstepA = 2 * hstepA, tstepB = 2 * hstepB;
    const unsigned ldsw = (unsigned)wid * 1024u;
    const int aoff = lds_byte(wr * 64 + fr, fq * 8), boff = lds_byte(wc * 32 + fr, fq * 8);
#define PG8_SA(b, h) (((b) * 2 + (h)) * HTB)
#define PG8_SB(b, h) ((4 + (b) * 2 + (h)) * HTB)
#define PG8_STAGE(bufoff, gbase, voff) do { _Pragma("unroll") for (int _i = 0; _i < 2; ++_i) \
        __builtin_amdgcn_global_load_lds((const GAS unsigned*)((const GAS char*)(gbase) + (voff)[_i]), (LAS unsigned*)(lds + (bufoff) + ldsw + _i * 8192), 16, 0, 0); } while (0)
#define PG8_LDA(dst, b, h) do { _Pragma("unroll") for (int m = 0; m < 4; ++m) _Pragma("unroll") for (int k = 0; k < 2; ++k) dst[m][k] = *(const LAS bf16x8*)(lds + PG8_SA(b, h) + aoff + m * 2048 + k * 1024); } while (0)
#define PG8_LDB(dst, b, h) do { _Pragma("unroll") for (int n = 0; n < 2; ++n) _Pragma("unroll") for (int k = 0; k < 2; ++k) dst[n][k] = *(const LAS bf16x8*)(lds + PG8_SB(b, h) + boff + n * 2048 + k * 1024); } while (0)
#define PG8_MMA(ai, bj, At, Bt) do { __builtin_amdgcn_s_setprio(1); _Pragma("unroll") for (int m = 0; m < 4; ++m) _Pragma("unroll") for (int n = 0; n < 2; ++n) _Pragma("unroll") for (int k = 0; k < 2; ++k) \
        acc[ai][bj][m][n] = Epi::I8 ? __builtin_bit_cast(f32x4, __builtin_amdgcn_mfma_i32_16x16x64_i8(__builtin_bit_cast(i32x4, Bt[n][k]), __builtin_bit_cast(i32x4, At[m][k]), __builtin_bit_cast(i32x4, acc[ai][bj][m][n]), 0, 0, 0)) \
            : __builtin_amdgcn_mfma_f32_16x16x32_bf16(Bt[n][k], At[m][k], acc[ai][bj][m][n], 0, 0, 0); __builtin_amdgcn_s_setprio(0); } while (0)
#define PG8_WAIT_V(n) asm volatile("s_waitcnt vmcnt(" #n ")" ::: "memory")
#define PG8_WAIT_L(n) asm volatile("s_waitcnt lgkmcnt(" #n ")" ::: "memory")
#define PG8_BAR __builtin_amdgcn_s_barrier()
#define PG8_SCHED __builtin_amdgcn_sched_barrier(0)
    Unit cur, nxt; int ui = 0;
    if (!S.next(0, cur)) return;
    f32x4 acc[2][2][4][2];
#pragma unroll
    for (int a = 0; a < 2; ++a)
#pragma unroll
        for (int b = 0; b < 2; ++b)
#pragma unroll
            for (int m = 0; m < 4; ++m)
#pragma unroll
                for (int n = 0; n < 2; ++n) acc[a][b][m][n] = (f32x4){0.f, 0.f, 0.f, 0.f};
    bf16x8 At[4][2], B0[2][2], B1[2][2];
    const GAS char* cA = (const GAS char*)g.A + (size_t)cur.pm * tstepA; const GAS char* cB = (const GAS char*)g.Bt + (size_t)cur.pn * tstepB;
    PG8_STAGE(PG8_SB(0, 0), cB, voffB); PG8_STAGE(PG8_SB(0, 1), cB + hstepB, voffB); PG8_STAGE(PG8_SA(0, 0), cA, voffA); PG8_STAGE(PG8_SA(0, 1), cA + hstepA, voffA);
    if (wr == 1) PG8_BAR;
    PG8_WAIT_V(2); PG8_BAR;
    PG8_STAGE(PG8_SB(1, 0), cB + kstep, voffB); PG8_STAGE(PG8_SA(1, 0), cA + kstep, voffA); PG8_STAGE(PG8_SB(1, 1), cB + hstepB + kstep, voffB);
    PG8_WAIT_V(6); PG8_BAR;
    for (;;) {
        const bool has_next = S.next(ui + 1, nxt);
        const GAS char* nA = has_next ? (const GAS char*)g.A + (size_t)nxt.pm * tstepA : cA; const GAS char* nB = has_next ? (const GAS char*)g.Bt + (size_t)nxt.pn * tstepB : cB;
        for (int t = 0; t < nt; t += 2) {
            const bool last = (t == nt - 2);
            size_t oA1, oA2, oB2;
            if constexpr (Epi::SEG) { constexpr int KS = Epi::KSEG; const int s0 = t / KS, t0 = t % KS, s2 = (t + 2) / KS, t2 = (t + 2) % KS;
                oA1 = (size_t)s0 * g.segA + (size_t)(t0 + 1) * kstep; oA2 = (size_t)s2 * g.segA + (size_t)t2 * kstep; oB2 = (size_t)s2 * g.segB + (size_t)t2 * kstep;
                if (t0 == 0 && t > 0) { if (wr == 0) PG8_BAR; E.mid(acc, cur, s0, wr, wc, fr, fq); if (wr == 1) PG8_BAR; } }
            else { oA1 = (size_t)(t + 1) * kstep; oA2 = (size_t)(t + 2) * kstep; oB2 = oA2; }
            const GAS char* a1 = cA + oA1;
            const GAS char* a2 = last ? nA : cA + oA2; const GAS char* b2 = last ? nB : cB + oB2;
            const GAS char* a3 = a2 + kstep; const GAS char* b3 = b2 + kstep;
            PG8_LDB(B0, 0, 0); PG8_LDB(B1, 0, 1); PG8_SCHED; PG8_LDA(At, 0, 0); PG8_STAGE(PG8_SA(1, 1), a1 + hstepA, voffA);
            PG8_WAIT_V(8); PG8_WAIT_L(0); PG8_BAR; PG8_MMA(0, 0, At, B0); PG8_MMA(0, 1, At, B1); PG8_BAR; PG8_SCHED;
            PG8_LDA(At, 0, 1); PG8_STAGE(PG8_SB(0, 0), b2, voffB); PG8_STAGE(PG8_SB(0, 1), b2 + hstepB, voffB); PG8_STAGE(PG8_SA(0, 0), a2, voffA);
            PG8_WAIT_V(8); PG8_WAIT_L(0); PG8_BAR; PG8_MMA(1, 0, At, B0); PG8_MMA(1, 1, At, B1); PG8_BAR; PG8_SCHED;
            PG8_LDB(B0, 1, 0); PG8_LDB(B1, 1, 1); PG8_SCHED; PG8_LDA(At, 1, 0); PG8_STAGE(PG8_SA(0, 1), a2 + hstepA, voffA);
            PG8_WAIT_V(8); PG8_WAIT_L(0); PG8_BAR; PG8_MMA(0, 0, At, B0); PG8_MMA(0, 1, At, B1); PG8_BAR; PG8_SCHED;
            PG8_LDA(At, 1, 1); PG8_STAGE(PG8_SB(1, 0), b3, voffB); PG8_STAGE(PG8_SB(1, 1), b3 + hstepB, voffB); PG8_STAGE(PG8_SA(1, 0), a3, voffA);
            PG8_WAIT_V(8); PG8_WAIT_L(0); PG8_BAR; PG8_MMA(1, 0, At, B0); PG8_MMA(1, 1, At, B1); PG8_BAR; PG8_SCHED;
        }
        if constexpr (ALIGN_EPI) { if (wr == 0) PG8_BAR; }
        E(acc, cur, wr, wc, fr, fq);
        if (!has_next) break;
#pragma unroll
        for (int a = 0; a < 2; ++a)
#pragma unroll
            for (int b = 0; b < 2; ++b)
#pragma unroll
                for (int m = 0; m < 4; ++m)
#pragma unroll
                    for (int n = 0; n < 2; ++n) acc[a][b][m][n] = (f32x4){0.f, 0.f, 0.f, 0.f};
        cur = nxt; cA = nA; cB = nB; ++ui;
        if constexpr (ALIGN_EPI) { if (wr == 1) PG8_BAR; }
    }
    PG8_WAIT_V(0);
    if constexpr (!ALIGN_EPI) { if (wr == 0) PG8_BAR; }
    PG8_BAR;
#undef PG8_SA
#undef PG8_SB
#undef PG8_STAGE
#undef PG8_LDA
#undef PG8_LDB
#undef PG8_MMA
#undef PG8_WAIT_V
#undef PG8_WAIT_L
#undef PG8_BAR
#undef PG8_SCHED
}
}

#define XB_TMO      128
#define XB_XCNT(j)  (256  + 64 * (j))
#define XB_XSUB(j)  (1280 + 64 * (j))
#define XB_XGEN(j)  (2304 + 64 * (j))
#define XB_TOP      3328
#define XB_TOPGEN   3392
#define XCD_BAR_WORDS 3456
#define XB_SPIN_CAP (1u << 18)
__device__ __forceinline__ unsigned xb_ld(unsigned* p)              { return __hip_atomic_load(p, __ATOMIC_RELAXED, __HIP_MEMORY_SCOPE_AGENT); }
__device__ __forceinline__ unsigned xb_add(unsigned* p, unsigned v) { return __hip_atomic_fetch_add(p, v, __ATOMIC_RELAXED, __HIP_MEMORY_SCOPE_AGENT); }
__device__ __forceinline__ unsigned xb_xcc_id() { return (unsigned)__builtin_amdgcn_s_getreg((3 << 11) | 20) & 0xFu; }
#define XB_SPIN(cond, bar) do { unsigned _sp = 0; while (cond) { __builtin_amdgcn_s_sleep(1); \
    if ((++_sp & 255u) == 0u) { if (xb_ld(&(bar)[XB_TMO])) break; if (_sp > XB_SPIN_CAP) { atomicAdd(&(bar)[XB_TMO], 1u); break; } } } } while (0)
struct XcdBarrier { unsigned* bar; unsigned x; volatile LAS unsigned* st; };
__device__ __forceinline__ XcdBarrier xcd_barrier_post(unsigned* bar, volatile LAS unsigned* st) {
    XcdBarrier b; b.bar = bar; b.x = xb_xcc_id(); b.st = st;
    if (threadIdx.x == 0) (void)xb_add(&bar[XB_XCNT(b.x)], 1u);
    return b;
}
__device__ __forceinline__ void xcd_barrier_complete(unsigned* bar, unsigned x, unsigned& nloc, unsigned& nx) {
    const unsigned G = gridDim.x * gridDim.y * gridDim.z;
    unsigned sum, cnt, mine, sp = 0u;
    for (;;) {
        sum = 0u; cnt = 0u;
        for (unsigned j = 0; j < 16; ++j) { const unsigned c = xb_ld(&bar[XB_XCNT(j)]); sum += c; cnt += (c > 0u) ? 1u : 0u; }
        mine = xb_ld(&bar[XB_XCNT(x)]);
        if (sum == G) break;
        __builtin_amdgcn_s_sleep(1);
        if ((++sp & 255u) == 0u) { if (xb_ld(&bar[XB_TMO])) break; if (sp > XB_SPIN_CAP) { atomicAdd(&bar[XB_TMO], 1u); break; } }
    }
    nloc = mine > 0u ? mine : 1u; nx = cnt > 0u ? cnt : 1u;
}
__device__ __forceinline__ void xcd_barrier(const XcdBarrier& b) {
    asm volatile("s_waitcnt vmcnt(0)" ::: "memory");
    __syncthreads();
    if (threadIdx.x == 0) {
        unsigned* bar = b.bar; asm volatile("" : "+s"(bar));
        __builtin_amdgcn_s_waitcnt(0);
        unsigned nloc = b.st[0], nx = b.st[1];
        if (nloc == 0u) { xcd_barrier_complete(bar, b.x, nloc, nx); b.st[0] = nloc; b.st[1] = nx; }
        const unsigned old = xb_add(&bar[XB_XSUB(b.x)], 1u);
        const unsigned gen = old / nloc;
        if (old + 1u == (gen + 1u) * nloc) {
            __builtin_amdgcn_fence(__ATOMIC_RELEASE, "agent");
            asm volatile("s_waitcnt vmcnt(0)" ::: "memory");
            const unsigned og = xb_add(&bar[XB_TOP], 1u);
            const unsigned tg = og / nx;
            if (og + 1u == (tg + 1u) * nx) xb_add(&bar[XB_TOPGEN], 1u);
            else XB_SPIN(xb_ld(&bar[XB_TOPGEN]) == tg, bar);
            __builtin_amdgcn_fence(__ATOMIC_ACQUIRE, "agent");
            xb_add(&bar[XB_XGEN(b.x)], 1u);
            asm volatile("s_waitcnt vmcnt(0)" ::: "memory");
        } else {
            XB_SPIN(xb_ld(&bar[XB_XGEN(b.x)]) == gen, bar);
            __builtin_amdgcn_fence(__ATOMIC_ACQUIRE, "agent");
            asm volatile("s_waitcnt vmcnt(0)" ::: "memory");
        }
    }
    __syncthreads();
}

#define LDS_WAIT() asm volatile("s_waitcnt lgkmcnt(0)" ::: "memory")
__device__ __forceinline__ float bf2f(unsigned short h) { return __builtin_bit_cast(float, (unsigned)h << 16); }
__device__ __forceinline__ float bflo(unsigned w) { return __builtin_bit_cast(float, w << 16); }
__device__ __forceinline__ float bfhi(unsigned w) { return __builtin_bit_cast(float, w & 0xffff0000u); }
__device__ __forceinline__ unsigned pk2(float lo, float hi) { return pg8::cvt_pk_bf16(lo, hi); }
__device__ __forceinline__ unsigned pk2_acc(float lo, float hi) {
    unsigned a = __builtin_bit_cast(unsigned, lo), b = __builtin_bit_cast(unsigned, hi);
    a += 0x7fffu + ((a >> 16) & 1u); b += 0x7fffu + ((b >> 16) & 1u); return (a >> 16) | (b & 0xffff0000u); }
__device__ __forceinline__ void unpack8(const u32x4 w, float (&f)[8]) {
#pragma unroll
    for (int q = 0; q < 4; ++q) { f[2 * q] = bflo(w[q]); f[2 * q + 1] = bfhi(w[q]); }
}
__device__ __forceinline__ u32x4 pack8(const float (&f)[8]) { u32x4 w; w.x = pk2(f[0], f[1]); w.y = pk2(f[2], f[3]); w.z = pk2(f[4], f[5]); w.w = pk2(f[6], f[7]); return w; }
__device__ __forceinline__ float wave_sum(float v) {
#pragma unroll
    for (int o = 1; o < 64; o <<= 1) v += __shfl_xor(v, o);
    return v;
}
__device__ __forceinline__ float wave_max(float v) {
#pragma unroll
    for (int o = 1; o < 64; o <<= 1) v = fmaxf(v, __shfl_xor(v, o));
    return v;
}
__device__ __forceinline__ float logsig(float x) { return fminf(x, 0.f) - log1pf(expf(-fabsf(x))); }
__device__ __forceinline__ float softplusf_(float x) { return fmaxf(x, 0.f) + log1pf(expf(-fabsf(x))); }
__device__ __forceinline__ float siluf_(float x) { return x * __builtin_amdgcn_rcpf(1.0f + __expf(-x)); }
__device__ __forceinline__ float clampf_(float x, float lo, float hi) { return fminf(fmaxf(x, lo), hi); }

__device__ const double ROPE_INV_TURNS[32] = {
    1.59154943091895346e-01, 1.19349369005342654e-01, 8.94994027620097804e-02, 6.71150846704077902e-02, 5.03292117661844479e-02, 3.77415881547067678e-02, 2.83021955739452893e-02, 2.12236531366118003e-02,
    1.59154945463488816e-02, 1.19349361890562274e-02, 8.94993956472293906e-03, 6.71150811130175919e-03, 5.03292153235746463e-03, 3.77415828186214788e-03, 2.83021961668436560e-03, 2.12236537295101661e-03,
    1.59154939534505145e-03, 1.19349373748529582e-03, 8.94994015762130509e-04, 6.71150796307716838e-04, 5.03292153235746485e-04, 3.77415865242362598e-04, 2.83021961668436560e-04, 2.12236529883872083e-04,
    1.59154950651349498e-04, 1.19349366337300012e-04, 8.94993978705982618e-05, 6.71150898212123409e-05, 5.03292153235746431e-05, 3.77415869874381108e-05, 2.83021957036418071e-05, 2.12236539147909035e-05};

struct Args { const float* in[18]; float* out; unsigned char* ws; int ph_lo, ph_hi, single, pad; };
struct KA {
    LAS unsigned char* lds;
    __device__ __forceinline__ unsigned long long ld(int i) const { volatile LAS unsigned* p = (volatile LAS unsigned*)(lds + MISC_OFF + 64) + 2 * i;
        const unsigned lo = __builtin_amdgcn_readfirstlane(p[0]), hi = __builtin_amdgcn_readfirstlane(p[1]); return ((unsigned long long)hi << 32) | lo; }
    __device__ __forceinline__ const GAS float* in(int i) const { return (const GAS float*)ld(i); }
    __device__ __forceinline__ GAS float* out() const { return (GAS float*)ld(18); }
    __device__ __forceinline__ GAS unsigned char* ws() const { return (GAS unsigned char*)ld(19); }
};

__device__ __forceinline__ bf16x8 frag_kc(const LAS bf16_t* X, int ld, int idx0, int k0, int lane) {
    return *(const LAS bf16x8*)(X + (idx0 + (lane & 15)) * ld + k0 + 8 * (lane >> 4));
}
__device__ __forceinline__ bf16x8 frag_ks(const LAS bf16_t* X, int ld, int idx0, int k0, int lane) {
    const LAS bf16_t* p = X + (k0 + 8 * (lane >> 4)) * ld + idx0 + (lane & 15);
    bf16x8 r;
#pragma unroll
    for (int i = 0; i < 8; ++i) r[i] = (short)p[i * ld];
    return r;
}
template <int MT, int NT, int KS, class FA, class FB, class EP>
__device__ __forceinline__ void tile_mm(int wave, int lane, FA&& fa, FB&& fb, EP&& epi) {
#pragma unroll
    for (int ti = 0; ti < (MT * NT) / 8; ++ti) {
        const int tix = wave + 8 * ti, mt = tix % MT, nt = tix / MT;
        f32x4 acc = (f32x4){0.f, 0.f, 0.f, 0.f};
#pragma unroll
        for (int ks = 0; ks < KS; ++ks) { const bf16x8 av = fa(mt * 16, ks), bv = fb(nt * 16, ks); acc = __builtin_amdgcn_mfma_f32_16x16x32_bf16(bv, av, acc, 0, 0, 0); }
        epi(mt * 16 + (lane & 15), nt * 16 + 4 * (lane >> 4), acc);
    }
}

template <bool MAP, int MODE = 0>
__device__ __forceinline__ void transpose_item(const GAS float* W, int K, int ldw, GAS bf16_t* WT, LAS float* scr, int kb, int nb, int lane, const GAS float* rowscale = nullptr, GAS unsigned* cmax = nullptr, int ncm = 0) {
    const int k0 = 64 * kb, n0 = 32 * nb;
    int nsrc = n0 + (lane & 31); if (MAP) nsrc = origcol(nsrc);
    float mx = 0.f, qs = 1.f;
    if (MODE == 2) { const float cm = __builtin_bit_cast(float, cmax[ncm + (lane & 31)]); qs = cm > 0.f ? 127.0f / cm : 0.f; }
#pragma unroll 8
    for (int i = 0; i < 32; ++i) { const int kk = 2 * i + (lane >> 5); float wv = (nsrc >= 0) ? W[(size_t)(k0 + kk) * ldw + nsrc] : 0.f; if (MAP) wv *= rowscale[k0 + kk];
        if (MODE == 1) mx = fmaxf(mx, fabsf(wv)); else scr[kk * 33 + (lane & 31)] = wv * qs; }
    if (MODE == 1) { mx = fmaxf(mx, __shfl_xor(mx, 32)); if (lane < 32) (void)__hip_atomic_fetch_max(cmax + ncm + lane, __builtin_bit_cast(unsigned, mx), __ATOMIC_RELAXED, __HIP_MEMORY_SCOPE_AGENT); return; }
    LDS_WAIT(); asm volatile("" ::: "memory");
    const int c = lane & 7;
#pragma unroll
    for (int j = 0; j < 4; ++j) { const int n = (lane >> 3) + 8 * j; const LAS float* s = scr + (8 * c) * 33 + n;
        if (MODE == 2) { unsigned q[8];
#pragma unroll
            for (int i = 0; i < 8; ++i) q[i] = (unsigned)(int)rintf(fminf(fmaxf(s[i * 33], -127.0f), 127.0f)) & 255u;
            u32x2 o; o.x = q[0] | (q[1] << 8) | (q[2] << 16) | (q[3] << 24); o.y = q[4] | (q[5] << 8) | (q[6] << 16) | (q[7] << 24);
            *(GAS u32x2*)((GAS unsigned char*)WT + (size_t)(ncm + n) * 1024 + k0 + 8 * c) = o; }
        else { u32x4 o; o.x = pk2(s[0 * 33], s[1 * 33]); o.y = pk2(s[2 * 33], s[3 * 33]); o.z = pk2(s[4 * 33], s[5 * 33]); o.w = pk2(s[6 * 33], s[7 * 33]);
            *(GAS u32x4*)(WT + (size_t)(n0 + n) * K + k0 + 8 * c) = o; } }
    LDS_WAIT(); asm volatile("" ::: "memory");
}
__device__ __forceinline__ void phase_weights(const KA a, LAS unsigned char* lds, int l, int gw, int ngw, int wave, int lane) {
    LAS float* scr = (LAS float*)(lds + wave * 8448);
    constexpr int I_IN = 16 * (NP / 32), I_UP1 = 8 * 32, I_OUT = 16 * 32;
    constexpr int NITEMS = I_IN + 4 * I_UP1 + I_OUT;
    for (int it = gw; it < NITEMS; it += ngw) {
        int r = it;
        if (r < I_IN) { const int kb = r / (NP / 32), nb = r % (NP / 32);
            const int tile = nb >> 3;
            if (tile < 24 && !is_sel8(tile)) transpose_item<true>(a.in(I_WIN) + (size_t)l * 1024 * NIN, 1024, NIN, (GAS bf16_t*)(a.ws() + WS_WIN), scr, kb, nb, lane, a.in(I_NORMW) + l * D);
            else transpose_item<true, 1>(a.in(I_WIN) + (size_t)l * 1024 * NIN, 1024, NIN, nullptr, scr, kb, nb, lane, a.in(I_NORMW) + l * D, (GAS unsigned*)(a.ws() + WS_CMAX) + l * N8,
                                         tile >= 24 ? (nb - PLD / 32) * 32 : 4096 + sel8inv(tile) * 256 + (nb & 7) * 32);
            continue; } r -= I_IN;
        if (r < 4 * I_UP1) { const int n = r / I_UP1; r %= I_UP1;
            transpose_item<false>(a.in(I_WUP) + ((size_t)l * 4 + n) * 512 * 1024, 512, 1024, (GAS bf16_t*)(a.ws() + WS_WUP) + (size_t)n * 1024 * 512, scr, r / 32, r % 32, lane); continue; } r -= 4 * I_UP1;
        transpose_item<false>(a.in(I_WOUT) + (size_t)l * 1024 * 1024, 1024, 1024, (GAS bf16_t*)(a.ws() + WS_WOUT), scr, r / 32, r % 32, lane);
    }
}
__device__ __forceinline__ void phase_wq(const KA a, LAS unsigned char* lds, int l, int gw, int ngw, int wave, int lane) {
    LAS float* scr = (LAS float*)(lds + wave * 8448);
    for (int it = gw; it < 16 * (N8 / 32); it += ngw) { const int kb = it / (N8 / 32), nbq = it % (N8 / 32);
        const int nb = nbq < 128 ? PLD / 32 + nbq : sel8((nbq - 128) >> 3) * 8 + (nbq & 7);
        transpose_item<true, 2>(a.in(I_WIN) + (size_t)l * 1024 * NIN, 1024, NIN, (GAS bf16_t*)(a.ws() + WS_W8), scr, kb, nb, lane, a.in(I_NORMW) + l * D, (GAS unsigned*)(a.ws() + WS_CMAX) + l * N8, nbq * 32); }
}
__device__ __forceinline__ void phase_rope(const KA a, int gtid, int nthr) {
    GAS float* ct = (GAS float*)(a.ws() + WS_ROPE); GAS float* st = ct + 4096 * 32;
    for (int idx = gtid; idx < 4096 * 32; idx += nthr) { const int pos = idx >> 5, j = idx & 31;
        const double t = (double)pos * ROPE_INV_TURNS[j]; const float fr = (float)(t - floor(t));
        ct[idx] = __builtin_amdgcn_cosf(fr); st[idx] = __builtin_amdgcn_sinf(fr); }
}
__device__ __forceinline__ void phase_x_in(const GAS float* xsrc, GAS bf16_t* x16, GAS float* rsq, GAS float* rinv, GAS unsigned char* x8, GAS float* sxi, int nrows, int gw, int ngw, int lane) {
    for (int m = gw; m < nrows; m += ngw) {
        const GAS f32x4* xr = (const GAS f32x4*)(xsrc + (size_t)m * D) + lane;
        f32x4 v[4]; float ss = 0.f;
#pragma unroll
        for (int j = 0; j < 4; ++j) { v[j] = xr[64 * j]; ss += (v[j].x * v[j].x + v[j].y * v[j].y) + (v[j].z * v[j].z + v[j].w * v[j].w); }
        ss = wave_sum(ss);
        GAS u32x2* o8 = (GAS u32x2*)(x16 + (size_t)m * D) + lane;
#pragma unroll
        for (int j = 0; j < 4; ++j) { u32x2 o; o.x = pk2(v[j].x, v[j].y); o.y = pk2(v[j].z, v[j].w); o8[64 * j] = o; }
        if (lane < 16) rsq[(size_t)m * 16 + lane] = (lane == 0) ? ss : 0.f;
        const float ri = 1.0f / sqrtf(ss * (1.0f / D) + EPS);
        float mx = 0.f;
#pragma unroll
        for (int j = 0; j < 4; ++j) { v[j] = v[j] * ri; mx = fmaxf(fmaxf(mx, fmaxf(fabsf(v[j].x), fabsf(v[j].y))), fmaxf(fabsf(v[j].z), fabsf(v[j].w))); }
        mx = wave_max(mx); const float sc = mx > 0.f ? 127.0f / mx : 0.f;
#pragma unroll
        for (int j = 0; j < 4; ++j) { const unsigned q = ((unsigned)(int)rintf(v[j].x * sc) & 255u) | (((unsigned)(int)rintf(v[j].y * sc) & 255u) << 8) | (((unsigned)(int)rintf(v[j].z * sc) & 255u) << 16) | (((unsigned)(int)rintf(v[j].w * sc) & 255u) << 24);
            ((GAS unsigned*)(x8 + (size_t)m * D))[lane + 64 * j] = q; }
        if (lane == 0) { rinv[m] = ri; sxi[m] = mx * (1.0f / 127.0f); }
    }
}
__device__ __forceinline__ void phase_x8(const GAS bf16_t* x16, const GAS float* rsq, GAS float* rinv, GAS unsigned char* x8, GAS float* sxi, int nrows, int gw, int ngw, int lane) {
    for (int m0 = gw; m0 < nrows; m0 += 4 * ngw) {
        u32x4 xa[4], xb[4]; float p[4];
#pragma unroll
        for (int r = 0; r < 4; ++r) { const int m = m0 + r * ngw; if (m < nrows) { const GAS u32x4* xr = (const GAS u32x4*)(x16 + (size_t)m * D) + lane * 2; xa[r] = xr[0]; xb[r] = xr[1]; p[r] = lane < 16 ? rsq[(size_t)m * 16 + lane] : 0.f; } }
#pragma unroll
        for (int r = 0; r < 4; ++r) { const int m = m0 + r * ngw; if (m < nrows) {
            float f[16]; { float t8[8]; unpack8(xa[r], t8);
#pragma unroll
                for (int i = 0; i < 8; ++i) f[i] = t8[i]; unpack8(xb[r], t8);
#pragma unroll
                for (int i = 0; i < 8; ++i) f[8 + i] = t8[i]; }
            const float ri = 1.0f / sqrtf(wave_sum(p[r]) * (1.0f / D) + EPS);
            float mx = 0.f;
#pragma unroll
            for (int i = 0; i < 16; ++i) { f[i] *= ri; mx = fmaxf(mx, fabsf(f[i])); }
            mx = wave_max(mx); const float sc = mx > 0.f ? 127.0f / mx : 0.f;
            u32x4 w;
#pragma unroll
            for (int q = 0; q < 4; ++q) w[q] = ((unsigned)(int)rintf(f[4 * q] * sc) & 255u) | (((unsigned)(int)rintf(f[4 * q + 1] * sc) & 255u) << 8) | (((unsigned)(int)rintf(f[4 * q + 2] * sc) & 255u) << 16) | (((unsigned)(int)rintf(f[4 * q + 3] * sc) & 255u) << 24);
            *(GAS u32x4*)(x8 + (size_t)m * D + lane * 16) = w;
            if (lane == 0) { rinv[m] = ri; sxi[m] = mx * (1.0f / 127.0f); } } }
    }
}
__device__ __forceinline__ void phase_final(const GAS bf16_t* x16, GAS float* out, const GAS float* w, int nrows, int gw, int ngw, int lane) {
    f32x4 wv[4];
#pragma unroll
    for (int j = 0; j < 4; ++j) wv[j] = ((const GAS f32x4*)w)[lane * 4 + j];
    for (int m = gw; m < nrows; m += ngw) {
        const GAS u32x4* xr = (const GAS u32x4*)(x16 + (size_t)m * D) + lane * 2;
        float f[16]; { float t8[8]; unpack8(xr[0], t8);
#pragma unroll
            for (int i = 0; i < 8; ++i) f[i] = t8[i]; unpack8(xr[1], t8);
#pragma unroll
            for (int i = 0; i < 8; ++i) f[8 + i] = t8[i]; }
        float ss = 0.f;
#pragma unroll
        for (int i = 0; i < 16; ++i) ss += f[i] * f[i];
        const float r = 1.0f / sqrtf(wave_sum(ss) * (1.0f / D) + EPS);
        GAS f32x4* orow = (GAS f32x4*)(out + (size_t)m * D) + lane * 4;
#pragma unroll
        for (int j = 0; j < 4; ++j) orow[j] = (f32x4){f[4 * j], f[4 * j + 1], f[4 * j + 2], f[4 * j + 3]} * r * wv[j];
    }
}

typedef short s16x4 __attribute__((ext_vector_type(4)));
__device__ __forceinline__ float logsig_f(float x) { return fminf(x, 0.f) - __logf(1.0f + __expf(-fabsf(x))); }
__device__ __forceinline__ float softplus_f(float x) { return fmaxf(x, 0.f) + __logf(1.0f + __expf(-fabsf(x))); }
__device__ __forceinline__ bf16x8 frag_tr(const LAS bf16_t* X, int ld, int idx0, int k0, int lane) {
    const LAS bf16_t* p = X + (k0 + 8 * (lane >> 4) + ((lane & 15) >> 2)) * ld + idx0 + 4 * (lane & 3);
    const s16x4 a = __builtin_amdgcn_ds_read_tr16_b64_v4i16((LAS s16x4*)p), b = __builtin_amdgcn_ds_read_tr16_b64_v4i16((LAS s16x4*)(p + 4 * ld));
    return (bf16x8){a[0], a[1], a[2], a[3], b[0], b[1], b[2], b[3]};
}
struct NormW { f32x4 w[4]; };
__device__ __forceinline__ void out128_tail(LAS unsigned char* lds, GAS bf16_t* P, int colg, const NormW& nw, const u32x4 g0, const u32x4 g1, int tid) {
    const int lane = tid & 63, wave = __builtin_amdgcn_readfirstlane(tid >> 6);
    const LAS bf16_t* AM = (const LAS bf16_t*)(lds + OFF_AM); const LAS bf16_t* V = (const LAS bf16_t*)(lds + OFF_V); const LAS bf16_t* ST = (const LAS bf16_t*)(lds + OFF_ST);
    LAS float* O = (LAS float*)(lds + OFF_O);
    tile_mm<4, 8, 4>(wave, lane,
        [&](int m0, int ks) { return frag_kc(AM, 136, m0, ks * 32, lane); },
        [&](int n0, int ks) { return ks < 2 ? frag_tr(V, LDV, n0, ks * 32, lane) : frag_kc(ST, 72, n0, (ks - 2) * 32, lane); },
        [&](int t, int v0, const f32x4& acc) { *(LAS f32x4*)(O + t * 132 + v0) = acc; });
    __syncthreads();
    const int t = tid >> 3, sub = tid & 7;
    f32x4 o[4]; float ss = 0.f;
#pragma unroll
    for (int j = 0; j < 4; ++j) { o[j] = *(const LAS f32x4*)(O + t * 132 + sub * 16 + 4 * j); ss += (o[j].x * o[j].x + o[j].y * o[j].y) + (o[j].z * o[j].z + o[j].w * o[j].w); }
    ss += __shfl_xor(ss, 1); ss += __shfl_xor(ss, 2); ss += __shfl_xor(ss, 4);
    const float r = __builtin_amdgcn_rsqf(ss * (1.0f / 128.0f) + EPS);
    GAS bf16_t* gp = P + (size_t)t * 512 + colg + sub * 16;
#pragma unroll
    for (int hh = 0; hh < 2; ++hh) {
        float g[8]; unpack8(hh == 0 ? g0 : g1, g);
        float res[8];
#pragma unroll
        for (int i = 0; i < 4; ++i) { res[i] = o[2 * hh][i] * r * nw.w[2 * hh][i] * siluf_(g[i]); res[4 + i] = o[2 * hh + 1][i] * r * nw.w[2 * hh + 1][i] * siluf_(g[4 + i]); }
        *(GAS u32x4*)(gp + 8 * hh) = pack8(res);
    }
}
__device__ __forceinline__ void local128_tail(LAS unsigned char* lds, GAS bf16_t* loc, int tid) {
    const int lane = tid & 63, wave = __builtin_amdgcn_readfirstlane(tid >> 6);
    const LAS bf16_t* V = (const LAS bf16_t*)(lds + OFF_V); const LAS bf16_t* KT = (const LAS bf16_t*)(lds + OFF_KT);
    tile_mm<8, 4, 2>(wave, lane,
        [&](int m0, int ks) { return frag_tr(V, LDV, m0, ks * 32, lane); },
        [&](int n0, int ks) { return frag_tr(KT, 72, n0, ks * 32, lane); },
        [&](int v, int k0, const f32x4& acc) { u32x2 w; w.x = pk2_acc(acc[0], acc[1]); w.y = pk2_acc(acc[2], acc[3]); *(GAS u32x2*)(loc + (size_t)v * 64 + k0) = w; });
}
struct VsgPre { u32x4 v0, v1, s0, s1, g0, g1; };
template <int PH>
__device__ __forceinline__ void vsg_load(VsgPre& p, const GAS bf16_t* P, int colv, int colg, const GAS bf16_t* S, int tid) {
    p.v0 = *(const GAS u32x4*)(P + pofs(tid >> 4, colv + (tid & 15) * 8));
    p.v1 = *(const GAS u32x4*)(P + pofs((tid >> 4) + 32, colv + (tid & 15) * 8));
    if (PH == 3) { p.s0 = *(const GAS u32x4*)(S + tid * 8); p.s1 = *(const GAS u32x4*)(S + (tid + 512) * 8);
        const GAS bf16_t* gp = P + pofs(tid >> 3, colg + (tid & 7) * 16); p.g0 = *(const GAS u32x4*)gp; p.g1 = *(const GAS u32x4*)(gp + 8); }
}
template <int PH>
__device__ __forceinline__ void vsg_store(const VsgPre& p, LAS unsigned char* lds, int tid) {
    LAS bf16_t* V = (LAS bf16_t*)(lds + OFF_V); LAS bf16_t* ST = (LAS bf16_t*)(lds + OFF_ST);
    *(LAS u32x4*)(V + (tid >> 4) * LDV + (tid & 15) * 8) = p.v0; *(LAS u32x4*)(V + ((tid >> 4) + 32) * LDV + (tid & 15) * 8) = p.v1;
    if (PH == 3) { *(LAS u32x4*)(ST + (tid >> 3) * 72 + (tid & 7) * 8) = p.s0; *(LAS u32x4*)(ST + ((tid >> 3) + 64) * 72 + (tid & 7) * 8) = p.s1; }
}

struct GlPre { VsgPre vsg; u32x4 lr, q, k; float w0, w1, bk, x0, x1, x2, x3; unsigned short z[8]; };
template <int BR, int PH>
__device__ __forceinline__ void gl_load(GlPre& p, GAS unsigned char* ws, const GAS float* pa, const GAS float* pb, int l, int u, int tid) {
    const int bl = u >> 8, h = (u >> 6) & 3, c = u & 63, lane = tid & 63, wave = __builtin_amdgcn_readfirstlane(tid >> 6);
    const GAS bf16_t* P = (const GAS bf16_t*)(ws + WS_PROJ) + (size_t)(bl * 64 + c) * (PLD * 64);
    constexpr int CQ = BR == 0 ? C_GQ : C_HQ, CK = BR == 0 ? C_GK : C_HF, CV = BR == 0 ? C_GV : C_HI, CG = BR == 0 ? C_GG : C_HG;
    if (BR == 0) {
        if (tid < 128) p.lr = *(const GAS u32x4*)(P + pofs(tid >> 1, C_LR + (tid & 1) * 8));
        p.w0 = pa[(size_t)l * 4096 + (tid >> 6) * 256 + h * 64 + lane]; p.w1 = pa[(size_t)l * 4096 + ((tid >> 6) + 8) * 256 + h * 64 + lane];
        p.bk = pb[l * 256 + h * 64 + lane];
    } else {
        const int ch = h * 64 + lane; p.x0 = pa[ch]; p.x1 = pa[256 + ch]; p.x2 = pa[512 + ch]; p.x3 = pa[768 + ch];
#pragma unroll
        for (int i = 0; i < 8; ++i) p.z[i] = P[pofs(wave * 8 + i, CK + h * 64 + lane)];
    }
    p.k = *(const GAS u32x4*)(P + pofs(tid >> 3, CK + h * 64 + (tid & 7) * 8));
    if (PH == 3) p.q = *(const GAS u32x4*)(P + pofs(tid >> 3, CQ + h * 64 + (tid & 7) * 8));
    vsg_load<1>(p.vsg, P, CV + h * 128, CG + h * 128, (const GAS bf16_t*)(ws + WS_STATE + BR * STATE_BR) + (size_t)((bl * 4 + h) * 64 + c) * 8192, tid);
}
template <int BR, int PH>
__device__ __forceinline__ void gl_compute(const GlPre& p, GAS unsigned char* ws, LAS unsigned char* lds, const NormW& nw, int l, int u, int tid) {
    const int bl = u >> 8, h = (u >> 6) & 3, c = u & 63, lane = tid & 63, wave = __builtin_amdgcn_readfirstlane(tid >> 6);
    GAS bf16_t* P = (GAS bf16_t*)(ws + WS_PROJ) + (size_t)(bl * 64 + c) * (PLD * 64);
    LAS float* CUM = (LAS float*)(lds + OFF_CUM); LAS float* SEG = (LAS float*)(lds + OFF_SEG);
    LAS bf16_t* QT = (LAS bf16_t*)(lds + OFF_QT); LAS bf16_t* KT = (LAS bf16_t*)(lds + OFF_KT); LAS bf16_t* AM = (LAS bf16_t*)(lds + OFF_AM);
    constexpr int CG = BR == 0 ? C_GG : C_HG;
    const int bh = bl * 4 + h, k = lane;
    u32x4 sv0, sv1, gv0, gv1;
    if (PH == 3) { const GAS bf16_t* S = (const GAS bf16_t*)(ws + WS_STATE + BR * STATE_BR) + (size_t)(bh * 64 + c) * 8192; sv0 = *(const GAS u32x4*)(S + tid * 8); sv1 = *(const GAS u32x4*)(S + (tid + 512) * 8);
        const GAS bf16_t* gp = P + pofs(tid >> 3, CG + h * 128 + (tid & 7) * 16); gv0 = *(const GAS u32x4*)gp; gv1 = *(const GAS u32x4*)(gp + 8); }
    __syncthreads();
    float lgv[8];
    if (BR == 0) {
        LAS bf16_t* LRB = (LAS bf16_t*)(lds + OFF_O); LAS bf16_t* WTB = LRB + 64 * 40; LAS float* BL = (LAS float*)(WTB + 64 * 40);
        if (tid < 128) { *(LAS u32x4*)(LRB + (tid >> 1) * 40 + (tid & 1) * 8) = p.lr; *(LAS u32x4*)(LRB + (tid >> 1) * 40 + 16 + (tid & 1) * 8) = (u32x4){0u, 0u, 0u, 0u}; }
        { const int r = tid >> 6; WTB[lane * 40 + r] = (bf16_t)(pk2(p.w0, 0.f) & 0xffffu); WTB[lane * 40 + 8 + r] = (bf16_t)(pk2(p.w1, 0.f) & 0xffffu); WTB[lane * 40 + 16 + r] = 0; WTB[lane * 40 + 24 + r] = 0; }
        if (wave == 0) BL[lane] = p.bk;
        __syncthreads();
        tile_mm<4, 4, 1>(wave, lane,
            [&](int m0, int) { return frag_kc(LRB, 40, m0, 0, lane); },
            [&](int n0, int) { return frag_kc(WTB, 40, n0, 0, lane); },
            [&](int t, int k0, const f32x4& acc) { const f32x4 b4 = *(const LAS f32x4*)(BL + k0); f32x4 o;
#pragma unroll
                for (int j = 0; j < 4; ++j) o[j] = logsig_f(acc[j] + b4[j]) * (1.0f / 16.0f);
                *(LAS f32x4*)(CUM + t * 68 + k0) = o; });
        __syncthreads();
#pragma unroll
        for (int i = 0; i < 8; ++i) lgv[i] = CUM[(wave * 8 + i) * 68 + k];
    } else {
        const float mx = fmaxf(fmaxf(p.x0, p.x1), fmaxf(p.x2, p.x3));
        const float e0 = __expf(p.x0 - mx), e1 = __expf(p.x1 - mx), e2 = __expf(p.x2 - mx), e3 = __expf(p.x3 - mx), inv = 1.0f / (e0 + e1 + e2 + e3);
        float lb = 0.f; if (l > 0) lb += e0 * inv; if (l > 1) lb += e1 * inv; if (l > 2) lb += e2 * inv;
        const float lbm = fmaxf(lb, 1e-30f);
        if (wave == 0) ((LAS float*)(lds + OFF_OML))[k] = 1.0f - lbm;
#pragma unroll
        for (int i = 0; i < 8; ++i) { const float z = bf2f(p.z[i]);
            const float s = __expf(-fabsf(z)); lgv[i] = __logf(((z >= 0.f) ? (1.0f + lbm * s) : (s + lbm)) * __builtin_amdgcn_rcpf(1.0f + s)); }
    }
#pragma unroll
    for (int i = 1; i < 8; ++i) lgv[i] += lgv[i - 1];
    SEG[wave * 64 + k] = lgv[7];
    __syncthreads();
    float pre = 0.f;
    for (int w = 0; w < wave; ++w) pre += SEG[w * 64 + k];
#pragma unroll
    for (int i = 0; i < 8; ++i) CUM[(wave * 8 + i) * 68 + k] = lgv[i] + pre;
    vsg_store<1>(p.vsg, lds, tid);
    if (PH == 3) { LAS bf16_t* ST = (LAS bf16_t*)(lds + OFF_ST); *(LAS u32x4*)(ST + (tid >> 3) * 72 + (tid & 7) * 8) = sv0; *(LAS u32x4*)(ST + ((tid >> 3) + 64) * 72 + (tid & 7) * 8) = sv1; }
    __syncthreads();
    {
        const int t = tid >> 3, k8 = (tid & 7) * 8;
        float kk[8]; unpack8(p.k, kk);
        if (BR == 1) {
#pragma unroll
            for (int i = 0; i < 8; ++i) kk[i] = ((const LAS float*)(lds + OFF_OML))[k8 + i] * __builtin_amdgcn_rcpf(1.0f + __expf(kk[i]));
        }
        const f32x4 c0 = *(const LAS f32x4*)(CUM + t * 68 + k8), c1 = *(const LAS f32x4*)(CUM + t * 68 + k8 + 4);
        const float ct[8] = {c0[0], c0[1], c0[2], c0[3], c1[0], c1[1], c1[2], c1[3]};
        if (PH == 3) {
            float q[8]; unpack8(p.q, q);
            const f32x4 m0 = *(const LAS f32x4*)(CUM + 31 * 68 + k8), m1 = *(const LAS f32x4*)(CUM + 31 * 68 + k8 + 4);
            const float cm[8] = {m0[0], m0[1], m0[2], m0[3], m1[0], m1[1], m1[2], m1[3]};
            const float qs = (BR == 0) ? 0.125f : 1.0f;
            float qt[8], kt[8], qh[8];
#pragma unroll
            for (int i = 0; i < 8; ++i) { const float d = clampf_(ct[i] - cm[i], -80.f, 80.f);
                qt[i] = q[i] * qs * __expf(d); kt[i] = kk[i] * __expf(-d); qh[i] = q[i] * qs * __expf(ct[i]); }
            *(LAS u32x4*)(QT + t * 72 + k8) = pack8(qt); *(LAS u32x4*)(KT + t * 72 + k8) = pack8(kt); *(LAS u32x4*)(AM + t * 136 + 64 + k8) = pack8(qh);
        } else {
            const f32x4 l0 = *(const LAS f32x4*)(CUM + 63 * 68 + k8), l1 = *(const LAS f32x4*)(CUM + 63 * 68 + k8 + 4);
            const float cl[8] = {l0[0], l0[1], l0[2], l0[3], l1[0], l1[1], l1[2], l1[3]};
            float kb[8];
#pragma unroll
            for (int i = 0; i < 8; ++i) kb[i] = kk[i] * __expf(cl[i] - ct[i]);
            *(LAS u32x4*)(KT + t * 72 + k8) = pack8(kb);
        }
    }
    __syncthreads();
    if (PH == 3) {
        tile_mm<4, 4, 2>(wave, lane,
            [&](int m0, int ks) { return frag_kc(QT, 72, m0, ks * 32, lane); },
            [&](int n0, int ks) { return frag_kc(KT, 72, n0, ks * 32, lane); },
            [&](int t, int s0, const f32x4& acc) { u32x2 w; w.x = pk2(s0 <= t ? acc[0] : 0.f, s0 + 1 <= t ? acc[1] : 0.f); w.y = pk2(s0 + 2 <= t ? acc[2] : 0.f, s0 + 3 <= t ? acc[3] : 0.f);
                *(LAS u32x2*)(AM + t * 136 + s0) = w; });
        __syncthreads();
        out128_tail(lds, (GAS bf16_t*)(ws + WS_OUTN + BR * OUTN_BR) + (size_t)(bl * SEQ + c * 64) * 512, h * 128, nw, gv0, gv1, tid);
    } else {
        local128_tail(lds, (GAS bf16_t*)(ws + WS_LOCAL + BR * LOCAL_BR) + (size_t)(bh * 64 + c) * 8192, tid);
        if (tid < 64) ((GAS float*)(ws + WS_DEC + BR * DEC_BR))[(size_t)(bh * 64 + c) * 64 + tid] = __expf(CUM[63 * 68 + tid]);
    }
}

struct RetPre { VsgPre vsg; u32x2 k1, k2, q1, q2; f32x4 cs, sn; };
template <int PH>
__device__ __forceinline__ void ret_load(RetPre& p, GAS unsigned char* ws, int u, int tid) {
    const int bl = u >> 8, h = (u >> 6) & 3, c = u & 63;
    const GAS bf16_t* P = (const GAS bf16_t*)(ws + WS_PROJ) + (size_t)(bl * 64 + c) * (PLD * 64);
    const int t = tid >> 3, j4 = (tid & 7) * 4, pos = c * 64 + t;
    const GAS float* ctab = (const GAS float*)(ws + WS_ROPE); const GAS float* stab = ctab + 4096 * 32;
    p.cs = *(const GAS f32x4*)(ctab + pos * 32 + j4); p.sn = *(const GAS f32x4*)(stab + pos * 32 + j4);
    p.k1 = *(const GAS u32x2*)(P + pofs(t, C_RK + h * 64 + j4)); p.k2 = *(const GAS u32x2*)(P + pofs(t, C_RK + h * 64 + 32 + j4));
    if (PH == 3) { p.q1 = *(const GAS u32x2*)(P + pofs(t, C_RQ + h * 64 + j4)); p.q2 = *(const GAS u32x2*)(P + pofs(t, C_RQ + h * 64 + 32 + j4)); }
    vsg_load<1>(p.vsg, P, C_RV + h * 128, C_RG + h * 128, (const GAS bf16_t*)(ws + WS_STATE + 2 * STATE_BR) + (size_t)((bl * 4 + h) * 64 + c) * 8192, tid);
}
template <int PH>
__device__ __forceinline__ void ret_compute(const RetPre& p, GAS unsigned char* ws, LAS unsigned char* lds, const NormW& nw, int u, int tid) {
    const int bl = u >> 8, h = (u >> 6) & 3, c = u & 63, lane = tid & 63, wave = __builtin_amdgcn_readfirstlane(tid >> 6);
    GAS bf16_t* P = (GAS bf16_t*)(ws + WS_PROJ) + (size_t)(bl * 64 + c) * (PLD * 64);
    LAS bf16_t* QT = (LAS bf16_t*)(lds + OFF_QT); LAS bf16_t* KT = (LAS bf16_t*)(lds + OFF_KT); LAS bf16_t* AM = (LAS bf16_t*)(lds + OFF_AM);
    const int bh = bl * 4 + h;
    const float lg = __logf(1.0f - exp2f(-5.0f - (float)h));
    u32x4 sv0, sv1, gv0, gv1;
    if (PH == 3) { const GAS bf16_t* S = (const GAS bf16_t*)(ws + WS_STATE + 2 * STATE_BR) + (size_t)(bh * 64 + c) * 8192; sv0 = *(const GAS u32x4*)(S + tid * 8); sv1 = *(const GAS u32x4*)(S + (tid + 512) * 8);
        const GAS bf16_t* gp = P + pofs(tid >> 3, C_RG + h * 128 + (tid & 7) * 16); gv0 = *(const GAS u32x4*)gp; gv1 = *(const GAS u32x4*)(gp + 8); }
    __syncthreads();
    {
        const int t = tid >> 3, j4 = (tid & 7) * 4;
        const f32x4 cs = p.cs, sn = p.sn;
        const float k1[4] = {bflo(p.k1.x), bfhi(p.k1.x), bflo(p.k1.y), bfhi(p.k1.y)}, k2[4] = {bflo(p.k2.x), bfhi(p.k2.x), bflo(p.k2.y), bfhi(p.k2.y)};
        float ka[4], kb[4];
#pragma unroll
        for (int i = 0; i < 4; ++i) { ka[i] = (k1[i] * cs[i] - k2[i] * sn[i]) * 0.125f; kb[i] = (k1[i] * sn[i] + k2[i] * cs[i]) * 0.125f; }
        if (PH == 3) {
            const float q1[4] = {bflo(p.q1.x), bfhi(p.q1.x), bflo(p.q1.y), bfhi(p.q1.y)}, q2[4] = {bflo(p.q2.x), bfhi(p.q2.x), bflo(p.q2.y), bfhi(p.q2.y)};
            float qa[4], qb[4];
#pragma unroll
            for (int i = 0; i < 4; ++i) { qa[i] = q1[i] * cs[i] - q2[i] * sn[i]; qb[i] = q1[i] * sn[i] + q2[i] * cs[i]; }
            const float gq = __expf(lg * (float)(t + 1));
            u32x2 w;
            w.x = pk2(qa[0], qa[1]); w.y = pk2(qa[2], qa[3]); *(LAS u32x2*)(QT + t * 72 + j4) = w;
            w.x = pk2(qb[0], qb[1]); w.y = pk2(qb[2], qb[3]); *(LAS u32x2*)(QT + t * 72 + 32 + j4) = w;
            w.x = pk2(ka[0], ka[1]); w.y = pk2(ka[2], ka[3]); *(LAS u32x2*)(KT + t * 72 + j4) = w;
            w.x = pk2(kb[0], kb[1]); w.y = pk2(kb[2], kb[3]); *(LAS u32x2*)(KT + t * 72 + 32 + j4) = w;
            w.x = pk2(qa[0] * gq, qa[1] * gq); w.y = pk2(qa[2] * gq, qa[3] * gq); *(LAS u32x2*)(AM + t * 136 + 64 + j4) = w;
            w.x = pk2(qb[0] * gq, qb[1] * gq); w.y = pk2(qb[2] * gq, qb[3] * gq); *(LAS u32x2*)(AM + t * 136 + 96 + j4) = w;
        } else {
            const float gk = __expf(lg * (float)(63 - t));
            u32x2 w;
            w.x = pk2(ka[0] * gk, ka[1] * gk); w.y = pk2(ka[2] * gk, ka[3] * gk); *(LAS u32x2*)(KT + t * 72 + j4) = w;
            w.x = pk2(kb[0] * gk, kb[1] * gk); w.y = pk2(kb[2] * gk, kb[3] * gk); *(LAS u32x2*)(KT + t * 72 + 32 + j4) = w;
        }
    }
    vsg_store<1>(p.vsg, lds, tid);
    __syncthreads();
    if (PH == 3) {
        tile_mm<4, 4, 2>(wave, lane,
            [&](int m0, int ks) { return frag_kc(QT, 72, m0, ks * 32, lane); },
            [&](int n0, int ks) { return frag_kc(KT, 72, n0, ks * 32, lane); },
            [&](int t, int s0, const f32x4& acc) { float r[4];
#pragma unroll
                for (int j = 0; j < 4; ++j) r[j] = acc[j] * __expf(lg * fabsf((float)(t - s0 - j)));
                u32x2 w; w.x = pk2(r[0], r[1]); w.y = pk2(r[2], r[3]); *(LAS u32x2*)(AM + t * 136 + s0) = w; });
        { LAS bf16_t* ST = (LAS bf16_t*)(lds + OFF_ST); *(LAS u32x4*)(ST + (tid >> 3) * 72 + (tid & 7) * 8) = sv0; *(LAS u32x4*)(ST + ((tid >> 3) + 64) * 72 + (tid & 7) * 8) = sv1; }
        __syncthreads();
        out128_tail(lds, (GAS bf16_t*)(ws + WS_OUTN + 3 * OUTN_BR) + (size_t)(bl * SEQ + c * 64) * 512, h * 128, nw, gv0, gv1, tid);
    } else {
        local128_tail(lds, (GAS bf16_t*)(ws + WS_LOCAL + 2 * LOCAL_BR) + (size_t)(bh * 64 + c) * 8192, tid);
        if (tid < 64) ((GAS float*)(ws + WS_DEC + 2 * DEC_BR))[(size_t)(bh * 64 + c) * 64 + tid] = __expf(64.0f * lg);
    }
}

constexpr int OFF_XB = OFF_ST;
struct MambaPre { u32x4 xb[7]; f32x4 cw; unsigned short raw; float dtb, alog; };
__device__ __forceinline__ int mamba_gch(int g, int lc) { return lc < 256 ? g * 256 + lc : lc < 320 ? 512 + g * 64 + (lc - 256) : 640 + g * 64 + (lc - 320); }
template <int PH>
__device__ __forceinline__ void mamba_load(MambaPre& p, GAS unsigned char* ws, const GAS float* convw, const GAS float* convb, const GAS float* dtb, const GAS float* alog, int l, int u, int tid) {
    const int bl = u >> 7, g = (u >> 6) & 1, c = u & 63, lane = tid & 63, wave = __builtin_amdgcn_readfirstlane(tid >> 6);
    const GAS bf16_t* PB = (const GAS bf16_t*)(ws + WS_PROJ);
    const GAS bf16_t* P = PB + (size_t)(bl * 64 + c) * (PLD * 64);
    if (tid < 256) { const int hh = g * 4 + wave; p.raw = P[pofs(lane, C_DT + hh)]; p.dtb = dtb[l * 8 + hh]; p.alog = alog[l * 8 + hh]; }
#pragma unroll
    for (int j = 0; j < 7; ++j) { const int id = tid + 512 * j, r = (int)(((unsigned)id * 2731u) >> 17), c8 = id - r * 48, pos = c * 64 + r - 3;
        p.xb[j] = (u32x4){0u, 0u, 0u, 0u};
        if (id < 67 * 48 && pos >= 0) p.xb[j] = *(const GAS u32x4*)(PB + (size_t)(bl * 64 + (pos >> 6)) * (PLD * 64) + pofs(pos & 63, C_SX + mamba_gch(g, c8 * 8))); }
    if (tid < 480) { const int w = (int)(((unsigned)tid * 683u) >> 16), lc = (tid - w * 96) * 4;
        p.cw = (tid < 384) ? *(const GAS f32x4*)(convw + (size_t)(l * 4 + w) * 768 + mamba_gch(g, lc)) : *(const GAS f32x4*)(convb + l * 768 + mamba_gch(g, (tid - 384) * 4)); }
}
template <int PH>
__device__ __forceinline__ void mamba_compute(const MambaPre& p, GAS unsigned char* ws, LAS unsigned char* lds, const GAS float* ssmd, const GAS float* snorm, int l, int u, int tid) {
    const int bl = u >> 7, g = (u >> 6) & 1, c = u & 63, lane = tid & 63, wave = __builtin_amdgcn_readfirstlane(tid >> 6);
    GAS bf16_t* P = (GAS bf16_t*)(ws + WS_PROJ) + (size_t)(bl * 64 + c) * (PLD * 64);
    LAS float* DT = (LAS float*)(lds + OFF_SEG); LAS float* CH = DT + 256;
    LAS bf16_t* QT = (LAS bf16_t*)(lds + OFF_QT); LAS bf16_t* KT = (LAS bf16_t*)(lds + OFF_KT); LAS bf16_t* AM = (LAS bf16_t*)(lds + OFF_AM);
    LAS bf16_t* V = (LAS bf16_t*)(lds + OFF_V); LAS bf16_t* ST = (LAS bf16_t*)(lds + OFF_ST); LAS bf16_t* XB = (LAS bf16_t*)(lds + OFF_XB);
    LAS float* CW = (LAS float*)(lds + OFF_AM);
    u32x4 stv[4], zv[4];
    if (PH == 3) {
#pragma unroll
        for (int e = 0; e < 4; ++e) stv[e] = *(const GAS u32x4*)((const GAS bf16_t*)(ws + WS_STATE + 3 * STATE_BR) + (size_t)((bl * 8 + g * 4 + e) * 64 + c) * 4096 + tid * 8);
#pragma unroll
        for (int j = 0; j < 4; ++j) zv[j] = *(const GAS u32x4*)(P + pofs(tid >> 3, C_SZ + g * 256 + (tid & 7) * 32 + 8 * j));
    }
    __syncthreads();
    if (tid < 256) {
        const float dt = softplus_f(bf2f(p.raw) + p.dtb);
        float x = -__expf(p.alog) * dt;
#pragma unroll
        for (int off = 1; off < 64; off <<= 1) { const float y = __shfl_up(x, off); if (lane >= off) x += y; }
        DT[wave * 64 + lane] = dt; CH[wave * 64 + lane] = x;
    }
#pragma unroll
    for (int j = 0; j < 7; ++j) { const int id = tid + 512 * j, r48 = (int)(((unsigned)id * 2731u) >> 17); if (id < 67 * 48) *(LAS u32x4*)(XB + r48 * 384 + (id - r48 * 48) * 8) = p.xb[j]; }
    if (tid < 480) *(LAS f32x4*)(CW + tid * 4) = p.cw;
    __syncthreads();
    if (tid < 480) {
        const int w96 = (int)(((unsigned)tid * 683u) >> 16), c4 = tid - w96 * 96, t0 = w96 * 13;
        f32x4 wv[4], xr[4];
        const f32x4 bv = *(const LAS f32x4*)(CW + 1536 + c4 * 4);
#pragma unroll
        for (int w = 0; w < 4; ++w) wv[w] = *(const LAS f32x4*)(CW + w * 384 + c4 * 4);
#pragma unroll
        for (int w = 0; w < 3; ++w) { const u32x2 xw = *(const LAS u32x2*)(XB + (t0 + w) * 384 + c4 * 4); xr[w] = (f32x4){bflo(xw.x), bfhi(xw.x), bflo(xw.y), bfhi(xw.y)}; }
#pragma unroll
        for (int j = 0; j < 13; ++j) {
            const int t = t0 + j;
            if (t < 64) {
                { const u32x2 xw = *(const LAS u32x2*)(XB + (t + 3) * 384 + c4 * 4); xr[(j + 3) & 3] = (f32x4){bflo(xw.x), bfhi(xw.x), bflo(xw.y), bfhi(xw.y)}; }
                f32x4 acc = bv + ((xr[j & 3] * wv[0] + xr[(j + 1) & 3] * wv[1]) + (xr[(j + 2) & 3] * wv[2] + xr[(j + 3) & 3] * wv[3]));
#pragma unroll
                for (int i = 0; i < 4; ++i) acc[i] = siluf_(acc[i]);
                if (c4 < 64) {
                    if (PH == 1) { const int e = c4 >> 4; acc = acc * (DT[e * 64 + t] * __expf(CH[e * 64 + 63] - CH[e * 64 + t])); }
                    u32x2 w; w.x = pk2(acc[0], acc[1]); w.y = pk2(acc[2], acc[3]); *(LAS u32x2*)(V + t * LDV + c4 * 4) = w;
                } else if (c4 < 80) { u32x2 w; w.x = pk2(acc[0], acc[1]); w.y = pk2(acc[2], acc[3]); *(LAS u32x2*)(KT + t * 72 + (c4 - 64) * 4) = w; }
                else { u32x2 w; w.x = pk2(acc[0], acc[1]); w.y = pk2(acc[2], acc[3]); *(LAS u32x2*)(QT + t * 72 + (c4 - 80) * 4) = w; }
            }
        }
    }
    __syncthreads();
    if (PH == 1) {
        GAS bf16_t* loc = (GAS bf16_t*)(ws + WS_LOCAL + 3 * LOCAL_BR);
        tile_mm<16, 4, 2>(wave, lane,
            [&](int m0, int ks) { return frag_tr(V, LDV, m0, ks * 32, lane); },
            [&](int n0, int ks) { return frag_tr(KT, 72, n0, ks * 32, lane); },
            [&](int hp, int m0, const f32x4& acc) { const int e = hp >> 6, pp = hp & 63; u32x2 w; w.x = pk2_acc(acc[0], acc[1]); w.y = pk2_acc(acc[2], acc[3]); *(GAS u32x2*)(loc + ((size_t)((bl * 8 + g * 4 + e) * 64 + c) * 64 + pp) * 64 + m0) = w; });
        if (tid < 256) ((GAS float*)(ws + WS_DEC + 3 * DEC_BR))[(size_t)((bl * 8 + g * 4 + wave) * 64 + c) * 64 + lane] = __expf(CH[wave * 64 + 63]);
    } else {
        LAS float* GS = (LAS float*)(lds + OFF_CUM);
        tile_mm<4, 4, 2>(wave, lane,
            [&](int m0, int ks) { return frag_kc(QT, 72, m0, ks * 32, lane); },
            [&](int n0, int ks) { return frag_kc(KT, 72, n0, ks * 32, lane); },
            [&](int t, int s0, const f32x4& acc) { *(LAS f32x4*)(GS + t * 68 + s0) = acc; });
        __syncthreads();
        LAS bf16_t* O16 = (LAS bf16_t*)(lds + OFF_O);
#pragma unroll
        for (int e = 0; e < 4; ++e) {
            const int hh = g * 4 + e;
            *(LAS u32x4*)(ST + (tid >> 3) * 72 + (tid & 7) * 8) = stv[e];
            { const int t = tid >> 3, s8 = (tid & 7) * 8; const float cht = CH[e * 64 + t];
              const f32x4 g0 = *(const LAS f32x4*)(GS + t * 68 + s8), g1 = *(const LAS f32x4*)(GS + t * 68 + s8 + 4);
              const f32x4 h0 = *(const LAS f32x4*)(CH + e * 64 + s8), h1 = *(const LAS f32x4*)(CH + e * 64 + s8 + 4);
              const f32x4 d0 = *(const LAS f32x4*)(DT + e * 64 + s8), d1 = *(const LAS f32x4*)(DT + e * 64 + s8 + 4);
              float pv[8];
#pragma unroll
              for (int i = 0; i < 8; ++i) { const int s = s8 + i; const float gv = (i < 4) ? g0[i & 3] : g1[i & 3], hs = (i < 4) ? h0[i & 3] : h1[i & 3], ds = (i < 4) ? d0[i & 3] : d1[i & 3];
                  pv[i] = (s <= t) ? gv * __expf(cht - hs) * ds : 0.f; }
              *(LAS u32x4*)(AM + t * 136 + s8) = pack8(pv);
              const u32x4 cw = *(const LAS u32x4*)(QT + t * 72 + s8); float cv[8]; unpack8(cw, cv); const float ec = __expf(cht);
#pragma unroll
              for (int i = 0; i < 8; ++i) cv[i] *= ec;
              *(LAS u32x4*)(AM + t * 136 + 64 + s8) = pack8(cv); }
            __syncthreads();
            const float Dh = ssmd[l * 8 + hh];
            tile_mm<4, 4, 4>(wave, lane,
                [&](int m0, int ks) { return frag_kc(AM, 136, m0, ks * 32, lane); },
                [&](int n0, int ks) { return ks < 2 ? frag_tr(V + e * 64, LDV, n0, ks * 32, lane) : frag_kc(ST, 72, n0, (ks - 2) * 32, lane); },
                [&](int t, int p0, const f32x4& acc) {
                    const u32x2 xw = *(const LAS u32x2*)(V + t * LDV + e * 64 + p0);
                    u32x2 w; w.x = pk2(acc[0] + Dh * bflo(xw.x), acc[1] + Dh * bfhi(xw.x)); w.y = pk2(acc[2] + Dh * bflo(xw.y), acc[3] + Dh * bfhi(xw.y));
                    *(LAS u32x2*)(O16 + t * LDV + e * 64 + p0) = w; });
            __syncthreads();
        }
        const int t = tid >> 3, sub = tid & 7;
        float y[32]; float ss = 0.f;
#pragma unroll
        for (int j = 0; j < 4; ++j) { const u32x4 w = *(const LAS u32x4*)(O16 + t * LDV + sub * 32 + 8 * j); float f[8], zf[8]; unpack8(w, f); unpack8(zv[j], zf);
#pragma unroll
            for (int i = 0; i < 8; ++i) { const float yy = f[i] * siluf_(zf[i]); y[8 * j + i] = yy; ss += yy * yy; } }
        ss += __shfl_xor(ss, 1); ss += __shfl_xor(ss, 2); ss += __shfl_xor(ss, 4);
        const float r = __builtin_amdgcn_rsqf(ss * (1.0f / 256.0f) + EPS);
        const GAS float* nwp = snorm + l * 512 + g * 256 + sub * 32;
        GAS bf16_t* op = (GAS bf16_t*)(ws + WS_OUTN + 2 * OUTN_BR) + (size_t)(bl * SEQ + c * 64 + t) * 512 + g * 256 + sub * 32;
        f32x4 w0 = *(const GAS f32x4*)nwp, w1 = *(const GAS f32x4*)(nwp + 4);
#pragma unroll
        for (int j = 0; j < 4; ++j) { float res[8];
#pragma unroll
            for (int i = 0; i < 4; ++i) { res[i] = y[8 * j + i] * r * w0[i]; res[4 + i] = y[8 * j + 4 + i] * r * w1[i]; }
            if (j < 3) { w0 = *(const GAS f32x4*)(nwp + 8 * j + 8); w1 = *(const GAS f32x4*)(nwp + 8 * j + 12); }
            *(GAS u32x4*)(op + 8 * j) = pack8(res); }
    }
}

template <int PH>
__device__ __forceinline__ void phase_mixer(const KA a, LAS unsigned char* lds, int l, int tid) {
    const int G = gridDim.x, bid = blockIdx.x;
    GAS unsigned char* ws = a.ws();
    for (int rep_ = 0; rep_ < ((PH == 3 && DUP_PHASE == 40) ? 2 : 1); ++rep_)
    {
        const GAS float* convw = a.in(I_CONVW); const GAS float* convb = a.in(I_CONVB); const GAS float* dtb = a.in(I_DTB); const GAS float* alog = a.in(I_ALOG); const GAS float* ssmd = a.in(I_SSMD); const GAS float* snorm = a.in(I_SNORM);
        MambaPre pre; int u = bid; if (u < 512) mamba_load<PH>(pre, ws, convw, convb, dtb, alog, l, u, tid);
        for (; u < 512; u += G) { const MambaPre cur = pre; if (u + G < 512) mamba_load<PH>(pre, ws, convw, convb, dtb, alog, l, u + G, tid); mamba_compute<PH>(cur, ws, lds, ssmd, snorm, l, u, tid); }
    }
    for (int rep_ = 0; rep_ < ((PH == 3 && DUP_PHASE == 41) ? 2 : 1); ++rep_)
    {
        const GAS float* wlr = a.in(I_WLR); const GAS float* blr = a.in(I_BLR); NormW nw;
        if (PH == 3) { const GAS float* np = a.in(I_GNORM) + l * 128 + (tid & 7) * 16;
#pragma unroll
            for (int j = 0; j < 4; ++j) nw.w[j] = *(const GAS f32x4*)(np + 4 * j); }
        GlPre pre; int u = bid; if (u < 1024) gl_load<0, PH>(pre, ws, wlr, blr, l, u, tid);
        for (; u < 1024; u += G) { const GlPre cur = pre; if (u + G < 1024) gl_load<0, PH>(pre, ws, wlr, blr, l, u + G, tid); gl_compute<0, PH>(cur, ws, lds, nw, l, u, tid); }
    }
    for (int rep_ = 0; rep_ < ((PH == 3 && DUP_PHASE == 42) ? 2 : 1); ++rep_)
    {
        const GAS float* hlb = a.in(I_HLB); NormW nw;
        if (PH == 3) { const GAS float* np = a.in(I_HNORM) + l * 128 + (tid & 7) * 16;
#pragma unroll
            for (int j = 0; j < 4; ++j) nw.w[j] = *(const GAS f32x4*)(np + 4 * j); }
        GlPre pre; int u = bid; if (u < 1024) gl_load<1, PH>(pre, ws, hlb, hlb, l, u, tid);
        for (; u < 1024; u += G) { const GlPre cur = pre; if (u + G < 1024) gl_load<1, PH>(pre, ws, hlb, hlb, l, u + G, tid); gl_compute<1, PH>(cur, ws, lds, nw, l, u, tid); }
    }
    for (int rep_ = 0; rep_ < ((PH == 3 && DUP_PHASE == 43) ? 2 : 1); ++rep_)
    {
        NormW nw;
        if (PH == 3) { const GAS float* np = a.in(I_RNORM) + l * 128 + (tid & 7) * 16;
#pragma unroll
            for (int j = 0; j < 4; ++j) nw.w[j] = *(const GAS f32x4*)(np + 4 * j); }
        RetPre pre; int u = bid; if (u < 1024) ret_load<PH>(pre, ws, u, tid);
        for (; u < 1024; u += G) { const RetPre cur = pre; if (u + G < 1024) ret_load<PH>(pre, ws, u + G, tid); ret_compute<PH>(cur, ws, lds, nw, u, tid); }
    }
    __syncthreads();
}

__device__ __forceinline__ void phase_scan(const KA a, int tid) {
    const int nthr = gridDim.x * 512;
    for (int gt = blockIdx.x * 512 + tid; gt < 4 * 32768; gt += nthr) {
        const int br = gt >> 15, r = gt & 32767;
        const int E = (br == 3) ? 4096 : 8192;
        const int per = E / 4;
        const int bh = r / per, e4 = r % per, k0 = (e4 * 4) & 63;
        const GAS bf16_t* loc = (const GAS bf16_t*)(a.ws() + WS_LOCAL + br * LOCAL_BR) + (size_t)bh * 64 * E + e4 * 4;
        const GAS float* dec = (const GAS float*)(a.ws() + WS_DEC + br * DEC_BR) + (size_t)bh * 64 * 64 + k0;
        GAS bf16_t* st = (GAS bf16_t*)(a.ws() + WS_STATE + br * STATE_BR) + (size_t)bh * 64 * E + e4 * 4;
        f32x4 S = (f32x4){0.f, 0.f, 0.f, 0.f};
        for (int c0 = 0; c0 < 64; c0 += 8) {
            u32x2 L[8]; f32x4 Dv[8];
#pragma unroll
            for (int i = 0; i < 8; ++i) { L[i] = *(const GAS u32x2*)(loc + (size_t)(c0 + i) * E); Dv[i] = *(const GAS f32x4*)(dec + (c0 + i) * 64); }
#pragma unroll
            for (int i = 0; i < 8; ++i) { u32x2 w; w.x = pk2(S.x, S.y); w.y = pk2(S.z, S.w); *(GAS u32x2*)(st + (size_t)(c0 + i) * E) = w;
                S = Dv[i] * S + (f32x4){bflo(L[i].x), bfhi(L[i].x), bflo(L[i].y), bfhi(L[i].y)}; }
        }
    }
}

constexpr int NPH_PER = 7, NPHASE = 1 + DEPTH * 2 * NPH_PER + 1;
__global__ void __launch_bounds__(512, 2) fwd(Args ka) {
    extern __shared__ __attribute__((aligned(16))) unsigned char lds_raw[];
    LAS unsigned char* lds = (LAS unsigned char*)lds_raw;
    const int tid = threadIdx.x, lane = tid & 63, wave = __builtin_amdgcn_readfirstlane(tid >> 6);
    const int G = gridDim.x;
    const int gw = blockIdx.x * 8 + wave, ngw = G * 8;
    volatile LAS unsigned* MISC = (volatile LAS unsigned*)(lds + MISC_OFF);
    if (tid < 16) MISC[tid] = 0u;
    if (tid < 18) ((volatile LAS unsigned long long*)(lds + MISC_OFF + 64))[tid] = (unsigned long long)ka.in[tid];
    if (tid == 18) ((volatile LAS unsigned long long*)(lds + MISC_OFF + 64))[18] = (unsigned long long)ka.out;
    if (tid == 19) ((volatile LAS unsigned long long*)(lds + MISC_OFF + 64))[19] = (unsigned long long)ka.ws;
    { unsigned w0 = 0u, w1 = 0u;
#pragma unroll
      for (int i = 0; i < 8; ++i) { const float zz = (float)(tid * 8 + i) * (1.0f / 256.0f) - 8.0f; const unsigned q = (unsigned)fminf(fmaxf(255.0f / (1.0f + expf(-zz)) + 0.5f, 1.0f), 255.0f); if (i < 4) w0 |= q << (8 * i); else w1 |= q << (8 * (i - 4)); }
      *(LAS u32x2*)(lds + OFF_LUT + tid * 8) = (u32x2){w0, w1}; }
    __syncthreads();
    const KA a{lds};
    const int ph_lo = ka.ph_lo, ph_hi = ka.ph_hi, single = ka.single;
    XcdBarrier bar; bar.bar = (unsigned*)(ka.ws + WS_CTL); bar.x = 0; bar.st = MISC + 8;
    if (single) bar = xcd_barrier_post((unsigned*)(ka.ws + WS_CTL), MISC + 8);
#define IN(p) (ph_lo <= (p) && (p) < ph_hi)
#define GRID_BAR() do { if (single) xcd_barrier(bar); } while (0)
#define OPQ_TID() ({ int t__ = threadIdx.x; asm volatile("" : "+v"(t__)); t__; })
    if (IN(0)) {
        const int t_ = OPQ_TID(), lane_ = t_ & 63, wave_ = __builtin_amdgcn_readfirstlane(t_ >> 6), gw_ = blockIdx.x * 8 + wave_;
        phase_weights(a, lds, 0, gw_, ngw, wave_, lane_); phase_rope(a, blockIdx.x * 512 + t_, G * 512);
        phase_x_in(a.in(I_X), (GAS bf16_t*)(a.ws() + WS_X16), (GAS float*)(a.ws() + WS_RSQ), (GAS float*)(a.ws() + WS_RINV), a.ws() + WS_X8, (GAS float*)(a.ws() + WS_SXI), BATCH * SEQ, gw_, ngw, lane_);
        GRID_BAR();
        phase_wq(a, lds, 0, gw_, ngw, wave_, lane_);
        GRID_BAR();
    }
    for (int l = 0; l < DEPTH; ++l) {
        for (int hf = 0; hf < 2; ++hf) {
            const int pb = 1 + (l * 2 + hf) * NPH_PER;
            const size_t rowoff = (size_t)hf * MH;
            GAS bf16_t* X16 = (GAS bf16_t*)(a.ws() + WS_X16) + rowoff * D;
            GAS float* RSQ = (GAS float*)(a.ws() + WS_RSQ) + rowoff * 16;
            GAS bf16_t* HB = (GAS bf16_t*)(a.ws() + WS_HB);
            GAS bf16_t* PROJ = (GAS bf16_t*)(a.ws() + WS_PROJ);
            if (EN_N && IN(pb + 0) && hf == 0 && l > 0) {
                const int t_ = OPQ_TID(), lane_ = t_ & 63, wave_ = __builtin_amdgcn_readfirstlane(t_ >> 6), gw_ = blockIdx.x * 8 + wave_;
                phase_weights(a, lds, l, gw_, ngw, wave_, lane_);
                GRID_BAR();
                phase_wq(a, lds, l, gw_, ngw, wave_, lane_);
                GRID_BAR();
            }
            if (EN_A && IN(pb + 1)) {
                pg8::Gemm g{X16, (const GAS bf16_t*)(a.ws() + WS_WIN), MH, 2048, D, D, D, 0, 0, 0}; pg8::StaticOrder S; S.init(MH, 2048, G, (int)blockIdx.x); S.keep = 1;
                pg8::EpiProj E{PROJ, (const GAS float*)(a.ws() + WS_RINV) + rowoff};
                if (SKEW_GROUPS > 1) {
                    const unsigned long long t0 = __builtin_amdgcn_s_memrealtime(), dl = (unsigned long long)((blockIdx.x / 8) % SKEW_GROUPS) * SKEW_TICKS;
                    while (__builtin_amdgcn_s_memrealtime() - t0 < dl) __builtin_amdgcn_s_sleep(8);
                }
                pg8::gemm_phase<pg8::EpiProj, true>(lds, g, S, E, OPQ_TID());
                {
                    pg8::Gemm g8{(const GAS bf16_t*)(a.ws() + WS_X8 + rowoff * D), (const GAS bf16_t*)(a.ws() + WS_W8), MH, N8, D / 2, D / 2, D / 2, 0, 0, 0}; pg8::StaticOrder S8; S8.init(MH, N8, G, (int)blockIdx.x);
                    pg8::EpiI8 E8{a.ws() + WS_GATES, PROJ, (const GAS float*)(a.ws() + WS_SXI) + rowoff, (const GAS unsigned*)(a.ws() + WS_CMAX) + l * N8, (const LAS unsigned char*)(lds + OFF_LUT)};
                    pg8::gemm_phase<pg8::EpiI8, true>(lds, g8, S8, E8, OPQ_TID()); }
                GRID_BAR();
            }
            if (EN_B1 && IN(pb + 2)) { phase_mixer<1>(a, lds, l, OPQ_TID()); GRID_BAR(); }
            if (EN_B2 && IN(pb + 3)) { const int t_ = OPQ_TID(); phase_scan(a, t_);
                if (!(l == DEPTH - 1 && hf == 1)) { const size_t oro = (size_t)(1 - hf) * MH; const int lane_ = t_ & 63, wave_ = __builtin_amdgcn_readfirstlane(t_ >> 6);
                  phase_x8((const GAS bf16_t*)(a.ws() + WS_X16) + oro * D, (const GAS float*)(a.ws() + WS_RSQ) + oro * 16, (GAS float*)(a.ws() + WS_RINV) + oro, a.ws() + WS_X8 + oro * D, (GAS float*)(a.ws() + WS_SXI) + oro, MH, blockIdx.x * 8 + wave_, G * 8, lane_); }
                GRID_BAR(); }
            if (EN_B3 && IN(pb + 4)) { for (int rep = 0; rep < (DUP_PHASE == 4 ? 2 : 1); ++rep) phase_mixer<3>(a, lds, l, OPQ_TID()); GRID_BAR(); }
            if (EN_C && IN(pb + 5)) {
                pg8::Gemm g{(const GAS bf16_t*)(a.ws() + WS_OUTN), (const GAS bf16_t*)(a.ws() + WS_WUP), MH, D, 2048, 512, 512, 8, OUTN_BR, (size_t)1024 * 512 * 2}; pg8::StaticOrder S; S.init(MH, D, G, (int)blockIdx.x);
                pg8::EpiUp E{a.ws() + WS_GATES, HB};
                pg8::gemm_phase<pg8::EpiUp, true>(lds, g, S, E, OPQ_TID());
                GRID_BAR();
            }
            if (EN_D && IN(pb + 6)) {
                pg8::Gemm g{HB, (const GAS bf16_t*)(a.ws() + WS_WOUT), MH, D, D, D, D, 0, 0, 0}; pg8::StaticOrder S; S.init(MH, D, G, (int)blockIdx.x);
                pg8::EpiOut E{X16, RSQ};
                pg8::gemm_phase<pg8::EpiOut, true>(lds, g, S, E, OPQ_TID());
                if (hf == 1 || !D_A_NOBAR) GRID_BAR();
            }
        }
    }
    if (IN(NPHASE - 1)) phase_final((const GAS bf16_t*)(a.ws() + WS_X16), a.out(), a.in(I_FNORM), BATCH * SEQ, gw, ngw, lane);
#undef IN
#undef GRID_BAR
}

extern "C" void kernel_launch(void* const* d_in, const int* in_sizes, int n_in, void* d_out, int out_size, void* d_ws, size_t ws_size, hipStream_t stream) {
    static int grid = 0;
    if (grid == 0) {
        if (n_in != 18 || in_sizes[0] != BATCH * SEQ * D || out_size != BATCH * SEQ * D || ws_size < WS_END) {
            fprintf(stderr, "kernel_launch: unexpected shapes (n_in %d, in0 %d, out %d, ws %zu, need %zu)\n", n_in, n_in > 0 ? in_sizes[0] : -1, out_size, ws_size, (size_t)WS_END); grid = -1; return; }
        int dev = 0, cus = 0, per_cu = 0;
        if (hipGetDevice(&dev) != hipSuccess || hipDeviceGetAttribute(&cus, hipDeviceAttributeMultiprocessorCount, dev) != hipSuccess) { grid = -1; return; }
        if (hipFuncSetAttribute((const void*)fwd, hipFuncAttributeMaxDynamicSharedMemorySize, LDS_BYTES) != hipSuccess) { fprintf(stderr, "kernel_launch: hipFuncSetAttribute failed\n"); grid = -1; return; }
        if (hipOccupancyMaxActiveBlocksPerMultiprocessor(&per_cu, (const void*)fwd, 512, LDS_BYTES) != hipSuccess || per_cu < 1)
            fprintf(stderr, "kernel_launch: occupancy query reports %d workgroups per CU\n", per_cu);
        (void)hipGetLastError();
        grid = cus;
    }
    if (grid < 0) return;
    (void)hipMemsetAsync((char*)d_ws + WS_CTL, 0, CTL_BYTES, stream);
    Args a{};
    for (int i = 0; i < 18; ++i) a.in[i] = (const float*)d_in[i];
    a.out = (float*)d_out; a.ws = (unsigned char*)d_ws; a.pad = 0;
#if MK_PER_PHASE_LAUNCH
    for (int p = 0; p < NPHASE; ++p) { a.ph_lo = p; a.ph_hi = p + 1; a.single = 0; hipLaunchKernelGGL(fwd, dim3(grid), dim3(512), LDS_BYTES, stream, a); }
#else
    a.ph_lo = 0; a.ph_hi = NPHASE; a.single = 1;
    hipLaunchKernelGGL(fwd, dim3(grid), dim3(512), LDS_BYTES, stream, a);
#endif
}
```
